# Optimizing an MI355X kernel written in HIP

```python
import math
import jax, jax.numpy as jnp
from jax import lax
import numpy as np

D_MODEL = 1024
BATCH = 16
SEQ = 4096
DEPTH = 4

CHUNK = 64
HEAD_DIM = 64
GROUP_WIDTH = D_MODEL // 4
N_HEADS = GROUP_WIDTH // HEAD_DIM
ROPE_THETA = 10000.0
NEG_INF = -1e30

A_PREV_CHUNKS = 8
REL_CLIP = 128
MLA_NOPE_DIM = HEAD_DIM
MLA_ROPE_DIM = HEAD_DIM // 2
MLA_V_DIM = HEAD_DIM
MLA_Q_RANK = 192
MLA_KV_RANK = 128
Q_BLOCK = 128
SWA_WINDOW = 128
SWA_PREV_CHUNKS = SWA_WINDOW // CHUNK
SWA_KV_HEADS = 2
MEM_LEN = 256
MEM_HEADS = 4

SPLIT_WIDTHS = (
    GROUP_WIDTH, GROUP_WIDTH, GROUP_WIDTH, GROUP_WIDTH,
    MLA_Q_RANK, MLA_KV_RANK, MLA_ROPE_DIM, GROUP_WIDTH,
    GROUP_WIDTH, SWA_KV_HEADS * HEAD_DIM, SWA_KV_HEADS * HEAD_DIM, GROUP_WIDTH,
    GROUP_WIDTH, GROUP_WIDTH,
)
PROJ_WIDTH = sum(SPLIT_WIDTHS)

kernel_name = 'hybrid_chunk_causal_head_groups'


def _split_points():
    pts, acc = [], 0
    for w in SPLIT_WIDTHS[:-1]:
        acc += w
        pts.append(acc)
    return pts


def _layer_norm(x, g, b, eps=1e-5):
    xf = x.astype(jnp.float32)
    mu = jnp.mean(xf, axis=-1, keepdims=True)
    var = jnp.mean(jnp.square(xf - mu), axis=-1, keepdims=True)
    y = (xf - mu) * lax.rsqrt(var + eps) * g.astype(jnp.float32) + b.astype(jnp.float32)
    return y.astype(x.dtype)


def _rms_norm(x, g, eps=1e-6):
    xf = x.astype(jnp.float32)
    y = xf * lax.rsqrt(jnp.mean(jnp.square(xf), axis=-1, keepdims=True) + eps) * g.astype(jnp.float32)
    return y.astype(x.dtype)


def _rope(x, positions):
    d = x.shape[-1]
    inv_freq = ROPE_THETA ** (-jnp.arange(0, d, 2, dtype=jnp.float32) / d)
    ang = positions.astype(jnp.float32)[..., None] * inv_freq
    cos = jnp.cos(ang)[:, :, None, :]
    sin = jnp.sin(ang)[:, :, None, :]
    x1, x2 = jnp.split(x.astype(jnp.float32), 2, axis=-1)
    out = jnp.concatenate([x1 * cos - x2 * sin, x2 * cos + x1 * sin], axis=-1)
    return out.astype(x.dtype)


def _banded_chunk_attention(q, k, v, n_prev, rel_bias=None, sinks=None):
    b, s, h, dh = q.shape
    kvh = k.shape[2]
    g = h // kvh
    nc = s // CHUNK
    pad = n_prev * CHUNK
    band = pad + CHUNK
    kp = jnp.pad(k, ((0, 0), (pad, 0), (0, 0), (0, 0)))
    vp = jnp.pad(v, ((0, 0), (pad, 0), (0, 0), (0, 0)))
    qc = q.reshape(b, nc, CHUNK, kvh, g, dh).transpose(1, 0, 2, 3, 4, 5)
    scale = dh ** -0.5
    kk = jnp.arange(band)
    if rel_bias is not None:
        rel = jnp.arange(CHUNK)[:, None] + pad - kk[None, :]
        idx = jnp.clip(rel, -REL_CLIP, REL_CLIP) + REL_CLIP
        bias = rel_bias[:, idx].astype(jnp.float32).reshape(kvh, g, CHUNK, band)

    def one_chunk(args):
        qb, c = args
        kb = lax.dynamic_slice_in_dim(kp, c * CHUNK, band, axis=1)
        vb = lax.dynamic_slice_in_dim(vp, c * CHUNK, band, axis=1)
        sc = jnp.einsum('bqkgd,bskd->bkgqs', qb, kb).astype(jnp.float32) * scale
        if rel_bias is not None:
            sc = sc + bias
        valid = (c * CHUNK - pad + kk) >= 0
        sc = jnp.where(valid, sc, NEG_INF)
        if sinks is not None:
            sink = jnp.broadcast_to(sinks.astype(jnp.float32).reshape(kvh, g, 1, 1), sc.shape[:-1] + (1,))
            p = jax.nn.softmax(jnp.concatenate([sc, sink], axis=-1), axis=-1)[..., :band]
        else:
            p = jax.nn.softmax(sc, axis=-1)
        o = jnp.einsum('bkgqs,bskd->bqkgd', p.astype(v.dtype), vb)
        return o.reshape(b, CHUNK, h, dh)

    out = lax.map(one_chunk, (qc, jnp.arange(nc)))
    return out.transpose(1, 0, 2, 3, 4).reshape(b, s, h * dh)


def _mla(c_q, c_kv, k_rope, positions, q_norm, w_uq, kv_norm, w_ukv):
    b, s, _ = c_q.shape
    q = (_rms_norm(c_q, q_norm) @ w_uq).reshape(b, s, N_HEADS, MLA_NOPE_DIM + MLA_ROPE_DIM)
    q_nope, q_rope = q[..., :MLA_NOPE_DIM], q[..., MLA_NOPE_DIM:]
    q_rope = _rope(q_rope, positions)
    kv = (_rms_norm(c_kv, kv_norm) @ w_ukv).reshape(b, s, N_HEADS, MLA_NOPE_DIM + MLA_V_DIM)
    k_nope, v = kv[..., :MLA_NOPE_DIM], kv[..., MLA_NOPE_DIM:]
    k_r = _rope(k_rope[:, :, None, :], positions)[:, :, 0, :]
    scale = (MLA_NOPE_DIM + MLA_ROPE_DIM) ** -0.5
    nb = s // Q_BLOCK
    qn = q_nope.reshape(b, nb, Q_BLOCK, N_HEADS, MLA_NOPE_DIM).transpose(1, 0, 2, 3, 4)
    qr = q_rope.reshape(b, nb, Q_BLOCK, N_HEADS, MLA_ROPE_DIM).transpose(1, 0, 2, 3, 4)
    key_chunk = jnp.arange(s) // CHUNK

    def one_block(args):
        qn_b, qr_b, i = args
        sc = (jnp.einsum('bqhd,bshd->bhqs', qn_b, k_nope)
              + jnp.einsum('bqhd,bsd->bhqs', qr_b, k_r)).astype(jnp.float32) * scale
        q_chunk = (i * Q_BLOCK + jnp.arange(Q_BLOCK)) // CHUNK
        mask = key_chunk[None, :] <= q_chunk[:, None]
        p = jax.nn.softmax(jnp.where(mask, sc, NEG_INF), axis=-1)
        return jnp.einsum('bhqs,bshd->bqhd', p.astype(v.dtype), v)

    out = lax.map(one_block, (qn, qr, jnp.arange(nb)))
    return out.transpose(1, 0, 2, 3, 4).reshape(b, s, N_HEADS * MLA_V_DIM)


def _memory_attention(q, mem, w_mem_kv):
    b, s, _ = q.shape
    qh = q.reshape(b, s, MEM_HEADS, HEAD_DIM)
    kv = (mem @ w_mem_kv).reshape(b, MEM_LEN, 2, MEM_HEADS, HEAD_DIM)
    k, v = kv[:, :, 0], kv[:, :, 1]
    sc = jnp.einsum('bqhd,bmhd->bhqm', qh, k).astype(jnp.float32) * (HEAD_DIM ** -0.5)
    p = jax.nn.softmax(sc, axis=-1)
    return jnp.einsum('bhqm,bmhd->bqhd', p.astype(v.dtype), v).reshape(b, s, MEM_HEADS * HEAD_DIM)


def _layer(x, mem, positions, w_in, rel_bias, mla_q_norm, w_uq, mla_kv_norm, w_ukv,
           swa_sinks, w_mem_kv, w_out, ln_gain, ln_bias):
    b, s, _ = x.shape
    proj = x @ w_in
    (aq, ak, av, ag, bcq, bckv, bkr, bg, cq, ck, cv, cg, mq, mg) = jnp.split(proj, _split_points(), axis=-1)

    ya = _banded_chunk_attention(aq.reshape(b, s, N_HEADS, HEAD_DIM),
                                 ak.reshape(b, s, N_HEADS, HEAD_DIM),
                                 av.reshape(b, s, N_HEADS, HEAD_DIM),
                                 A_PREV_CHUNKS, rel_bias=rel_bias)
    yb = _mla(bcq, bckv, bkr, positions, mla_q_norm, w_uq, mla_kv_norm, w_ukv)
    qc = _rope(cq.reshape(b, s, N_HEADS, HEAD_DIM), positions)
    kc = _rope(ck.reshape(b, s, SWA_KV_HEADS, HEAD_DIM), positions)
    yc = _banded_chunk_attention(qc, kc, cv.reshape(b, s, SWA_KV_HEADS, HEAD_DIM),
                                 SWA_PREV_CHUNKS, sinks=swa_sinks)
    ym = _memory_attention(mq, mem, w_mem_kv)

    gated = jnp.concatenate([ya * jax.nn.silu(ag), yb * jax.nn.silu(bg),
                             yc * jax.nn.silu(cg), ym * jax.nn.silu(mg)], axis=-1)
    y = gated @ w_out
    alpha = (2.0 * DEPTH) ** 0.25
    return _layer_norm(alpha * x + y, ln_gain, ln_bias)


def setup_inputs(seed: int = 0) -> dict:
    key = jax.random.key(seed)
    ks = jax.random.split(key, 16)
    f32 = jnp.float32
    beta = (8.0 * DEPTH) ** -0.25
    x = jax.random.normal(ks[0], (BATCH, SEQ, D_MODEL), f32)
    mem = jax.random.normal(ks[1], (BATCH, MEM_LEN, D_MODEL), f32)
    offset = jax.random.randint(ks[2], (BATCH, 1), 0, 4096, dtype=jnp.int32)
    positions = offset + jnp.arange(SEQ, dtype=jnp.int32)[None, :]
    w_in = jax.random.normal(ks[3], (DEPTH, D_MODEL, PROJ_WIDTH), f32) * D_MODEL ** -0.5
    rel_bias = jax.random.normal(ks[4], (DEPTH, N_HEADS, 2 * REL_CLIP + 1), f32) * 0.5
    mla_q_norm = 1.0 + 0.02 * jax.random.normal(ks[5], (DEPTH, MLA_Q_RANK), f32)
    w_uq = jax.random.normal(ks[6], (DEPTH, MLA_Q_RANK, N_HEADS * (MLA_NOPE_DIM + MLA_ROPE_DIM)), f32) * MLA_Q_RANK ** -0.5
    mla_kv_norm = 1.0 + 0.02 * jax.random.normal(ks[7], (DEPTH, MLA_KV_RANK), f32)
    w_ukv = jax.random.normal(ks[8], (DEPTH, MLA_KV_RANK, N_HEADS * (MLA_NOPE_DIM + MLA_V_DIM)), f32) * MLA_KV_RANK ** -0.5
    swa_sinks = jax.random.normal(ks[9], (DEPTH, N_HEADS), f32) * 0.5
    w_mem_kv = jax.random.normal(ks[10], (DEPTH, D_MODEL, 2 * MEM_HEADS * HEAD_DIM), f32) * D_MODEL ** -0.5
    w_out = jax.random.normal(ks[11], (DEPTH, D_MODEL, D_MODEL), f32) * (D_MODEL ** -0.5) * beta
    ln_gain = 1.0 + 0.02 * jax.random.normal(ks[12], (DEPTH, D_MODEL), f32)
    ln_bias = 0.02 * jax.random.normal(ks[13], (DEPTH, D_MODEL), f32)
    return {'x': x, 'mem': mem, 'positions': positions, 'w_in': w_in, 'rel_bias': rel_bias,
            'mla_q_norm': mla_q_norm, 'w_uq': w_uq, 'mla_kv_norm': mla_kv_norm, 'w_ukv': w_ukv,
            'swa_sinks': swa_sinks, 'w_mem_kv': w_mem_kv, 'w_out': w_out,
            'ln_gain': ln_gain, 'ln_bias': ln_bias}


def reference(x, mem, positions, w_in, rel_bias, mla_q_norm, w_uq, mla_kv_norm, w_ukv,
              swa_sinks, w_mem_kv, w_out, ln_gain, ln_bias):
    h = x
    for l in range(DEPTH):
        h = _layer(h, mem, positions, w_in[l], rel_bias[l], mla_q_norm[l], w_uq[l],
                   mla_kv_norm[l], w_ukv[l], swa_sinks[l], w_mem_kv[l], w_out[l],
                   ln_gain[l], ln_bias[l])
    return h
```

```cpp
#include <hip/hip_runtime.h>
#include <hip/hip_cooperative_groups.h>
#include <cstdio>
namespace cg = cooperative_groups;

typedef unsigned short u16;
typedef short bf16x8 __attribute__((ext_vector_type(8)));
typedef float f32x16 __attribute__((ext_vector_type(16)));
typedef __bf16 bf16x2_t __attribute__((ext_vector_type(2)));
typedef float f32x2_t __attribute__((ext_vector_type(2)));
typedef unsigned u32x4 __attribute__((ext_vector_type(4)));
typedef unsigned u32x2 __attribute__((ext_vector_type(2)));
typedef float f32x4 __attribute__((ext_vector_type(4)));

#define DI __device__ __forceinline__
#define MFMA(a, b, c) __builtin_amdgcn_mfma_f32_32x32x16_bf16((a), (b), (c), 0, 0, 0)

constexpr int T_TOK = 65536;
constexpr int SEQ = 4096;
constexpr int NBATCH = 16;
constexpr int DM = 1024;
constexpr int NP = 2944;
constexpr int PW = 2912;
constexpr int DEPTH = 4;
constexpr int C_AQ = 0, C_AK = 256, C_AV = 512, C_AG = 768;
constexpr int C_CQ = 1024, C_CK = 1280, C_CV = 1408, C_CG = 1536;
constexpr int C_MQ = 1792, C_MG = 2048;
constexpr int C_BG = 2304, C_BCQ = 2560, C_BCKV = 2752, C_BKR = 2880;

constexpr float LOG2E = 1.4426950408889634f;
constexpr float QS64 = 0.125f * LOG2E;
constexpr float QS96 = 0.10206207261596575f * LOG2E;

constexpr size_t AL(size_t x) { return (x + 255) & ~(size_t)255; }
constexpr size_t OFF_WIN = 0;
constexpr size_t OFF_WOUT = OFF_WIN + AL((size_t)DEPTH * NP * DM * 2);
constexpr size_t OFF_WUQ = OFF_WOUT + AL((size_t)DEPTH * DM * DM * 2);
constexpr size_t OFF_WUKV = OFF_WUQ + AL((size_t)DEPTH * 384 * 192 * 2);
constexpr size_t OFF_WMKV = OFF_WUKV + AL((size_t)DEPTH * 512 * 128 * 2);
constexpr size_t OFF_MEMB = OFF_WMKV + AL((size_t)DEPTH * 512 * 1024 * 2);
constexpr size_t OFF_KMEM = OFF_MEMB + AL((size_t)4096 * 1024 * 2);
constexpr size_t OFF_VTMEM = OFF_KMEM + AL((size_t)DEPTH * 4096 * 256 * 2);
constexpr size_t OFF_COS64 = OFF_VTMEM + AL((size_t)DEPTH * 4096 * 256 * 2);
constexpr size_t OFF_SIN64 = OFF_COS64 + AL((size_t)T_TOK * 32 * 4);
constexpr size_t OFF_COS32 = OFF_SIN64 + AL((size_t)T_TOK * 32 * 4);
constexpr size_t OFF_SIN32 = OFF_COS32 + AL((size_t)T_TOK * 16 * 4);
constexpr size_t OFF_XB = OFF_SIN32 + AL((size_t)T_TOK * 16 * 4);
constexpr size_t OFF_PROJ = OFF_XB + AL((size_t)T_TOK * DM * 2);
constexpr size_t OFF_VTA = OFF_PROJ + AL((size_t)T_TOK * NP * 2);
constexpr size_t OFF_VTC = OFF_VTA + AL((size_t)T_TOK * 256 * 2);
constexpr size_t OFF_VTB = OFF_VTC + AL((size_t)T_TOK * 128 * 2);
constexpr size_t OFF_QB = OFF_VTB + AL((size_t)T_TOK * 256 * 2);
constexpr size_t OFF_KB = OFF_QB + AL((size_t)T_TOK * 384 * 2);
constexpr size_t OFF_GATED = OFF_KB + AL((size_t)T_TOK * 384 * 2);
constexpr size_t OFF_CTR = OFF_GATED + AL((size_t)T_TOK * DM * 2);
constexpr size_t WS_NEEDED = OFF_CTR + 256;

constexpr int SM_AS = 0;
constexpr int SM_BS = 256 * 72 * 2;
constexpr int SM_RS = SM_BS + 128 * 72 * 2;
constexpr int SM_GEMM_END = SM_RS + 1024;
constexpr int SM_K = 0;
constexpr int SM_VT = 17408;
constexpr int SM_BIAS = 34816;
constexpr int SM_ITEM = SM_BIAS + 4128;
constexpr int SM_TOTAL = SM_GEMM_END;

struct Params {
  const float* x; const float* mem; const int* pos;
  const float* w_in; const float* rel_bias; const float* q_norm; const float* w_uq;
  const float* kv_norm; const float* w_ukv; const float* sinks; const float* w_mem_kv;
  const float* w_out; const float* ln_g; const float* ln_b;
  float* out; char* ws;
};

DI float bf2f(u16 v) { return __uint_as_float(((unsigned)v) << 16); }
DI unsigned pack2(float a, float b) {
  f32x2_t v = {a, b};
  bf16x2_t r = __builtin_convertvector(v, bf16x2_t);
  return __builtin_bit_cast(unsigned, r);
}
DI u32x4 mk4(unsigned a, unsigned b, unsigned c, unsigned d) { u32x4 v = {a, b, c, d}; return v; }
DI u32x2 mk2(unsigned a, unsigned b) { u32x2 v = {a, b}; return v; }
DI int opaque_tid() { int t = threadIdx.x; asm volatile("" : "+v"(t)); return t; }
DI float lo_f(unsigned u) { return __uint_as_float(u << 16); }
DI float hi_f(unsigned u) { return __uint_as_float(u & 0xffff0000u); }
DI float fast_exp2(float x) { return __builtin_amdgcn_exp2f(x); }
DI float silu_f(float g) { return g * __builtin_amdgcn_rcpf(1.0f + fast_exp2(-g * LOG2E)); }

DI int win_colmap(int n, float& sc) {
  sc = 1.0f;
  if (n < 1024) { if (n < 256) sc = QS64; return n; }
  if (n < 1280) { sc = QS64; return 1632 + (n - 1024); }
  if (n < 1408) return 1888 + (n - 1280);
  if (n < 1536) return 2016 + (n - 1408);
  if (n < 1792) return 2144 + (n - 1536);
  if (n < 2048) { sc = QS64; return 2400 + (n - 1792); }
  if (n < 2304) return 2656 + (n - 2048);
  if (n < 2560) return 1376 + (n - 2304);
  if (n < 2752) return 1024 + (n - 2560);
  if (n < 2880) return 1216 + (n - 2752);
  if (n < 2912) return 1344 + (n - 2880);
  sc = 0.0f; return 0;
}

DI void transpose_tile(const Params& p, int l, int job, int kt, int nt, float* tile) {
  const int tid = opaque_tid();
  const float* src; int lds_; u16* dst; int ldd; const float* kscale = nullptr; float kconst = 1.0f;
  char* ws = p.ws;
  if (job == 0) { src = p.w_in + (size_t)l * DM * PW; lds_ = PW; dst = (u16*)(ws + OFF_WIN) + (size_t)l * NP * DM; ldd = DM; }
  else if (job == 1) { src = p.w_out + (size_t)l * DM * DM; lds_ = DM; dst = (u16*)(ws + OFF_WOUT) + (size_t)l * DM * DM; ldd = DM; }
  else if (job == 2) { src = p.w_uq + (size_t)l * 192 * 384; lds_ = 384; dst = (u16*)(ws + OFF_WUQ) + (size_t)l * 384 * 192; ldd = 192; kscale = p.q_norm + l * 192; kconst = QS96; }
  else if (job == 3) { src = p.w_ukv + (size_t)l * 128 * 512; lds_ = 512; dst = (u16*)(ws + OFF_WUKV) + (size_t)l * 512 * 128; ldd = 128; kscale = p.kv_norm + l * 128; }
  else { src = p.w_mem_kv + (size_t)l * 1024 * 512; lds_ = 512; dst = (u16*)(ws + OFF_WMKV) + (size_t)l * 512 * 1024; ldd = 1024; }
  const int k0 = kt * 64, n0 = nt * 64;
  {
    const int nx = tid & 63;
    const int n = n0 + nx;
    int col; float sc = 1.0f;
    if (job == 0) col = win_colmap(n, sc);
    else if (job == 2) col = (n < 256) ? ((n >> 6) * 96 + (n & 63)) : (((n - 256) >> 5) * 96 + 64 + ((n - 256) & 31));
    else if (job == 3) col = (n < 256) ? ((n >> 6) * 128 + (n & 63)) : (((n - 256) >> 6) * 128 + 64 + ((n - 256) & 63));
    else col = n;
    sc *= kconst;
#pragma unroll 4
    for (int i = 0; i < 16; ++i) {
      const int ky = i * 4 + (tid >> 6);
      float v = src[(size_t)(k0 + ky) * lds_ + col] * sc;
      if (kscale) v *= kscale[k0 + ky];
      tile[ky * 65 + nx] = v;
    }
  }
  __syncthreads();
  {
    const int n = tid >> 2, kc = (tid & 3) * 16;
    unsigned w[8];
#pragma unroll
    for (int i = 0; i < 8; ++i) w[i] = pack2(tile[(kc + 2 * i) * 65 + n], tile[(kc + 2 * i + 1) * 65 + n]);
    u32x4* d = (u32x4*)(dst + (size_t)(n0 + n) * ldd + k0 + kc);
    d[0] = mk4(w[0], w[1], w[2], w[3]);
    d[1] = mk4(w[4], w[5], w[6], w[7]);
  }
  __syncthreads();
}

DI void sincos_reduced(double ang, float& c, float& s) {
  const double TWO_PI = 6.283185307179586476925287;
  double k = rint(ang * (1.0 / TWO_PI));
  double r = fma(-k, TWO_PI, ang);
  double r2 = r * r;
  double sp = -1.0 / 15511210043330985984000000.0;
  double ss = 1.0 / 15511210043330985984000000.0;
  ss = fma(ss, r2, -1.0 / 25852016738884976640000.0);
  ss = fma(ss, r2, 1.0 / 51090942171709440000.0);
  ss = fma(ss, r2, -1.0 / 121645100408832000.0);
  ss = fma(ss, r2, 1.0 / 355687428096000.0);
  ss = fma(ss, r2, -1.0 / 1307674368000.0);
  ss = fma(ss, r2, 1.0 / 6227020800.0);
  ss = fma(ss, r2, -1.0 / 39916800.0);
  ss = fma(ss, r2, 1.0 / 362880.0);
  ss = fma(ss, r2, -1.0 / 5040.0);
  ss = fma(ss, r2, 1.0 / 120.0);
  ss = fma(ss, r2, -1.0 / 6.0);
  ss = fma(ss, r2, 1.0);
  ss *= r;
  (void)sp;
  double cc = 1.0 / 620448401733239439360000.0;
  cc = fma(cc, r2, -1.0 / 1124000727777607680000.0);
  cc = fma(cc, r2, 1.0 / 2432902008176640000.0);
  cc = fma(cc, r2, -1.0 / 6402373705728000.0);
  cc = fma(cc, r2, 1.0 / 20922789888000.0);
  cc = fma(cc, r2, -1.0 / 87178291200.0);
  cc = fma(cc, r2, 1.0 / 479001600.0);
  cc = fma(cc, r2, -1.0 / 3628800.0);
  cc = fma(cc, r2, 1.0 / 40320.0);
  cc = fma(cc, r2, -1.0 / 720.0);
  cc = fma(cc, r2, 1.0 / 24.0);
  cc = fma(cc, r2, -0.5);
  cc = fma(cc, r2, 1.0);
  c = (float)cc; s = (float)ss;
}

DI void phase0(const Params& p, char* smem) {
  const int tid = opaque_tid();
  const size_t gtid = (size_t)blockIdx.x * 256 + tid;
  const size_t gn = (size_t)gridDim.x * 256;
  char* ws = p.ws;
  if (blockIdx.x == 0 && tid < 64) ((int*)(ws + OFF_CTR))[tid] = 0;
  {
    u16* xb = (u16*)(ws + OFF_XB);
    const size_t n8 = (size_t)T_TOK * DM / 8;
    for (size_t i = gtid; i < n8; i += gn) {
      const f32x4 a = ((const f32x4*)p.x)[2 * i], b = ((const f32x4*)p.x)[2 * i + 1];
      ((u32x4*)xb)[i] = mk4(pack2(a.x, a.y), pack2(a.z, a.w), pack2(b.x, b.y), pack2(b.z, b.w));
    }
    u16* mb = (u16*)(ws + OFF_MEMB);
    const size_t m8 = (size_t)4096 * 1024 / 8;
    for (size_t i = gtid; i < m8; i += gn) {
      const f32x4 a = ((const f32x4*)p.mem)[2 * i], b = ((const f32x4*)p.mem)[2 * i + 1];
      ((u32x4*)mb)[i] = mk4(pack2(a.x, a.y), pack2(a.z, a.w), pack2(b.x, b.y), pack2(b.z, b.w));
    }
  }
  {
    float* c64 = (float*)(ws + OFF_COS64); float* s64 = (float*)(ws + OFF_SIN64);
    float* c32 = (float*)(ws + OFF_COS32); float* s32 = (float*)(ws + OFF_SIN32);
    const double L2T = 13.287712379549449;
    for (size_t i = gtid; i < (size_t)T_TOK * 48; i += gn) {
      const int tok = (int)(i / 48), j = (int)(i % 48);
      const double pos = (double)p.pos[tok];
      float c, s;
      if (j < 32) {
        const float invf = (float)exp2(-(double)(2 * j) / 64.0 * L2T);
        const float angf = (float)pos * invf;
        sincos_reduced((double)angf, c, s);
        c64[(size_t)tok * 32 + j] = c; s64[(size_t)tok * 32 + j] = s;
      } else {
        const int jj = j - 32;
        const float invf = (float)exp2(-(double)(2 * jj) / 32.0 * L2T);
        const float angf = (float)pos * invf;
        sincos_reduced((double)angf, c, s);
        c32[(size_t)tok * 16 + jj] = c; s32[(size_t)tok * 16 + jj] = s;
      }
    }
  }
  {
    float* tile = (float*)smem;
    for (int t = blockIdx.x; t < DEPTH * 1154; t += gridDim.x) {
      const int l = t / 1154; int u = t % 1154;
      if (u < 736) transpose_tile(p, l, 0, u / 46, u % 46, tile);
      else if ((u -= 736) < 256) transpose_tile(p, l, 1, u / 16, u % 16, tile);
      else if ((u -= 256) < 18) transpose_tile(p, l, 2, u / 6, u % 6, tile);
      else if ((u -= 18) < 16) transpose_tile(p, l, 3, u / 8, u % 8, tile);
      else { u -= 16; transpose_tile(p, l, 4, u / 8, u % 8, tile); }
    }
  }
}

enum { M_ROW = 0, M_TR = 1, M_UQ = 2, M_UKVK = 3, M_UKVV = 4, M_G3 = 5 };

struct Epi {
  u16* out; int out_ld;
  u16* vt; int seq; int nseg0; int hrows;
  const float* c32; const float* s32;
  const float* xprev; float* xout;
};

template <int MODE>
DI void gemm_tile(const u16* __restrict__ A, int lda, const u16* __restrict__ Bt, int ldb, int K,
                          int m0, int n0, const Epi& e, char* smem) {
  constexpr bool SWAP = (MODE == M_ROW || MODE == M_UQ || MODE == M_UKVK || MODE == M_G3);
  const int tid = opaque_tid(), lane = tid & 63, wave = tid >> 6, r = lane & 31, h = lane >> 5;
  const int wm = wave >> 1, wn = wave & 1;
  u16* As = (u16*)(smem + SM_AS);
  u16* Bs = (u16*)(smem + SM_BS);
  const float* rs = (const float*)(smem + SM_RS);
  f32x16 acc[4][2];
#pragma unroll
  for (int i = 0; i < 4; ++i)
#pragma unroll
    for (int j = 0; j < 2; ++j)
#pragma unroll
      for (int q = 0; q < 16; ++q) acc[i][j][q] = 0.f;

  const int crow_ = tid >> 3, ccol = (tid & 7) * 8;
  const u16* Ag = A + (size_t)(m0 + crow_) * lda + ccol;
  const u16* Bg = Bt + (size_t)(n0 + crow_) * ldb + ccol;
  u32x4 ra[8], rb[4];
#pragma unroll
  for (int i = 0; i < 8; ++i) ra[i] = *(const u32x4*)(Ag + (size_t)(32 * i) * lda);
#pragma unroll
  for (int i = 0; i < 4; ++i) rb[i] = *(const u32x4*)(Bg + (size_t)(32 * i) * ldb);
#pragma unroll
  for (int i = 0; i < 8; ++i) *(u32x4*)(As + (crow_ + 32 * i) * 72 + ccol) = ra[i];
#pragma unroll
  for (int i = 0; i < 4; ++i) *(u32x4*)(Bs + (crow_ + 32 * i) * 72 + ccol) = rb[i];
  __syncthreads();
  const int KT = K >> 6;
  const u16* Ar = As + (wm * 128 + r) * 72 + 8 * h;
  const u16* Br = Bs + (wn * 64 + r) * 72 + 8 * h;
  for (int kt = 0; kt < KT; ++kt) {
    const bool more = (kt + 1 < KT);
    if (more) {
      const int k0 = (kt + 1) * 64;
#pragma unroll
      for (int i = 0; i < 8; ++i) ra[i] = *(const u32x4*)(Ag + (size_t)(32 * i) * lda + k0);
#pragma unroll
      for (int i = 0; i < 4; ++i) rb[i] = *(const u32x4*)(Bg + (size_t)(32 * i) * ldb + k0);
    }
#pragma unroll
    for (int ks = 0; ks < 4; ++ks) {
      bf16x8 af[4], bfr[2];
#pragma unroll
      for (int mb = 0; mb < 4; ++mb) af[mb] = *(const bf16x8*)(Ar + mb * 32 * 72 + ks * 16);
#pragma unroll
      for (int nb = 0; nb < 2; ++nb) bfr[nb] = *(const bf16x8*)(Br + nb * 32 * 72 + ks * 16);
#pragma unroll
      for (int mb = 0; mb < 4; ++mb)
#pragma unroll
        for (int nb = 0; nb < 2; ++nb) {
          if (SWAP) acc[mb][nb] = MFMA(bfr[nb], af[mb], acc[mb][nb]);
          else acc[mb][nb] = MFMA(af[mb], bfr[nb], acc[mb][nb]);
        }
    }
    __syncthreads();
    if (more) {
#pragma unroll
      for (int i = 0; i < 8; ++i) *(u32x4*)(As + (crow_ + 32 * i) * 72 + ccol) = ra[i];
#pragma unroll
      for (int i = 0; i < 4; ++i) *(u32x4*)(Bs + (crow_ + 32 * i) * 72 + ccol) = rb[i];
    }
    __syncthreads();
  }

  if (SWAP) {
#pragma unroll
    for (int mb = 0; mb < 4; ++mb) {
      const int ml = wm * 128 + mb * 32 + r;
      const int m = m0 + ml;
      float rsv = 1.0f;
      if (MODE == M_UQ || MODE == M_UKVK) rsv = rs[ml];
#pragma unroll
      for (int nb = 0; nb < 2; ++nb) {
        const int nbase = n0 + wn * 64 + nb * 32;
        if (MODE == M_ROW) {
#pragma unroll
          for (int g = 0; g < 4; ++g) {
            const int n = nbase + 8 * g + 4 * h;
            u32x2 v = mk2(pack2(acc[mb][nb][4 * g], acc[mb][nb][4 * g + 1]), pack2(acc[mb][nb][4 * g + 2], acc[mb][nb][4 * g + 3]));
            *(u32x2*)(e.out + (size_t)m * e.out_ld + n) = v;
          }
        } else if (MODE == M_UKVK) {
#pragma unroll
          for (int g = 0; g < 4; ++g) {
            const int n = nbase + 8 * g + 4 * h;
            u32x2 v = mk2(pack2(acc[mb][nb][4 * g] * rsv, acc[mb][nb][4 * g + 1] * rsv), pack2(acc[mb][nb][4 * g + 2] * rsv, acc[mb][nb][4 * g + 3] * rsv));
            *(u32x2*)(e.out + (size_t)m * 384 + (n >> 6) * 96 + (n & 63)) = v;
          }
        } else if (MODE == M_UQ) {
          if (n0 < 256) {
#pragma unroll
            for (int g = 0; g < 4; ++g) {
              const int n = nbase + 8 * g + 4 * h;
              u32x2 v = mk2(pack2(acc[mb][nb][4 * g] * rsv, acc[mb][nb][4 * g + 1] * rsv), pack2(acc[mb][nb][4 * g + 2] * rsv, acc[mb][nb][4 * g + 3] * rsv));
              *(u32x2*)(e.out + (size_t)m * 384 + (n >> 6) * 96 + (n & 63)) = v;
            }
          } else {
            const int head = wn * 2 + nb;
#pragma unroll
            for (int g = 0; g < 2; ++g) {
              const int d = 8 * g + 4 * h;
              const f32x4 cs = *(const f32x4*)(e.c32 + (size_t)m * 16 + d);
              const f32x4 sn = *(const f32x4*)(e.s32 + (size_t)m * 16 + d);
              const float c_[4] = {cs.x, cs.y, cs.z, cs.w}, s_[4] = {sn.x, sn.y, sn.z, sn.w};
              float o1[4], o2[4];
#pragma unroll
              for (int j = 0; j < 4; ++j) {
                const float x1 = acc[mb][nb][4 * g + j] * rsv, x2 = acc[mb][nb][4 * (g + 2) + j] * rsv;
                o1[j] = x1 * c_[j] - x2 * s_[j];
                o2[j] = x2 * c_[j] + x1 * s_[j];
              }
              u16* dst = e.out + (size_t)m * 384 + head * 96 + 64 + d;
              *(u32x2*)dst = mk2(pack2(o1[0], o1[1]), pack2(o1[2], o1[3]));
              *(u32x2*)(dst + 16) = mk2(pack2(o2[0], o2[1]), pack2(o2[2], o2[3]));
            }
          }
        } else if (MODE == M_G3) {
          const float alpha = 1.681792830507429f;
#pragma unroll
          for (int g = 0; g < 4; ++g) {
            const int n = nbase + 8 * g + 4 * h;
            const f32x4 xv = *(const f32x4*)(e.xprev + (size_t)m * DM + n);
            f32x4 o;
            o.x = alpha * xv.x + acc[mb][nb][4 * g];
            o.y = alpha * xv.y + acc[mb][nb][4 * g + 1];
            o.z = alpha * xv.z + acc[mb][nb][4 * g + 2];
            o.w = alpha * xv.w + acc[mb][nb][4 * g + 3];
            *(f32x4*)(e.xout + (size_t)m * DM + n) = o;
          }
        }
      }
    }
  } else {
    const int b = m0 / e.seq, s0 = m0 % e.seq;
#pragma unroll
    for (int nb = 0; nb < 2; ++nb) {
      const int n = n0 + wn * 64 + nb * 32 + r;
      u16* rowp = e.vt + ((size_t)b * e.hrows + (n - e.nseg0)) * e.seq + s0;
#pragma unroll
      for (int mb = 0; mb < 4; ++mb) {
#pragma unroll
        for (int g = 0; g < 4; ++g) {
          const int ml = wm * 128 + mb * 32 + 8 * g + 4 * h;
          float v0 = acc[mb][nb][4 * g], v1 = acc[mb][nb][4 * g + 1], v2 = acc[mb][nb][4 * g + 2], v3 = acc[mb][nb][4 * g + 3];
          if (MODE == M_UKVV) {
            const f32x4 rv = *(const f32x4*)(rs + ml);
            v0 *= rv.x; v1 *= rv.y; v2 *= rv.z; v3 *= rv.w;
          }
          *(u32x2*)(rowp + ml) = mk2(pack2(v0, v1), pack2(v2, v3));
        }
      }
    }
  }
}

DI void compute_rs(const u16* proj, int m0, int col0, int kdim, char* smem) {
  float* rs = (float*)(smem + SM_RS);
  const int tid = opaque_tid();
  const u16* rowp = proj + (size_t)(m0 + tid) * NP + col0;
  float ss = 0.f;
  for (int c = 0; c < kdim; c += 8) {
    const u32x4 v = *(const u32x4*)(rowp + c);
    const unsigned w[4] = {v.x, v.y, v.z, v.w};
#pragma unroll
    for (int i = 0; i < 4; ++i) { const float a = lo_f(w[i]), b = hi_f(w[i]); ss += a * a + b * b; }
  }
  rs[tid] = rsqrtf(ss / (float)kdim + 1e-6f);
}

struct AttnBlk {
  const u16* k; int k_ld;
  const u16* vt; int vt_ld;
  int kt_begin, kt_end;
  int c;
};
struct AttnWave {
  const u16* q; int q_ld;
  const u16* gate;
  u16* out;
  int hoff;
  int my_kt_end;
  float m_init; float l_init;
  const float* bias;
  int qi0;
};

template <int DQK, int NH, int MODE>
DI void attn_item(const AttnBlk& ab, const AttnWave& aw, char* smem) {
  constexpr int KCOLS = NH * DQK;
  constexpr int KROWB = (KCOLS + 8) * 2;
  constexpr int CPR = KCOLS / 8;
  constexpr int NKC = (64 * CPR) / 256;
  constexpr int NVC = 2 * NH;
  constexpr int NKS = DQK / 16;
  const int tid = opaque_tid(), lane = tid & 63, r = lane & 31, h = lane >> 5;
  char* Kl = smem + SM_K;
  char* Vl = smem + SM_VT;

  bf16x8 qf[NKS];
#pragma unroll
  for (int ks = 0; ks < NKS; ++ks) qf[ks] = *(const bf16x8*)(aw.q + (size_t)r * aw.q_ld + ks * 16 + 8 * h);

  f32x16 o0, o1;
#pragma unroll
  for (int i = 0; i < 16; ++i) { o0[i] = 0.f; o1[i] = 0.f; }
  float m = aw.m_init, l = aw.l_init;

  u32x4 rk[NKC], rv[NVC];
  auto gload = [&](int kt) {
#pragma unroll
    for (int i = 0; i < NKC; ++i) {
      const int id = tid + 256 * i, row = id / CPR, cc = id % CPR;
      rk[i] = *(const u32x4*)(ab.k + (size_t)(kt * 64 + row) * ab.k_ld + cc * 8);
    }
#pragma unroll
    for (int i = 0; i < NVC; ++i) {
      const int id = tid + 256 * i, row = id >> 3, cc = id & 7;
      rv[i] = *(const u32x4*)(ab.vt + (size_t)row * ab.vt_ld + kt * 64 + cc * 8);
    }
  };
  auto swrite = [&]() {
#pragma unroll
    for (int i = 0; i < NKC; ++i) {
      const int id = tid + 256 * i, row = id / CPR, cc = id % CPR;
      *(u32x4*)(Kl + row * KROWB + cc * 16) = rk[i];
    }
#pragma unroll
    for (int i = 0; i < NVC; ++i) {
      const int id = tid + 256 * i, row = id >> 3, cc = id & 7;
      u32x2* d = (u32x2*)(Vl + row * 136 + cc * 16);
      d[0] = mk2(rv[i].x, rv[i].y);
      d[1] = mk2(rv[i].z, rv[i].w);
    }
  };

  gload(ab.kt_begin);
  swrite();
  __syncthreads();
  const char* kl = Kl + r * KROWB + (aw.hoff * DQK + 8 * h) * 2;
  const char* vl = Vl + (aw.hoff * 64 + r) * 136 + (4 * h) * 2;
  for (int kt = ab.kt_begin; kt < ab.kt_end; ++kt) {
    const bool more = (kt + 1 < ab.kt_end);
    if (more) gload(kt + 1);
    if (kt < aw.my_kt_end) {
      f32x16 s0, s1;
#pragma unroll
      for (int i = 0; i < 16; ++i) { s0[i] = 0.f; s1[i] = 0.f; }
#pragma unroll
      for (int ks = 0; ks < NKS; ++ks) {
        const bf16x8 k0f = *(const bf16x8*)(kl + ks * 32);
        const bf16x8 k1f = *(const bf16x8*)(kl + 32 * KROWB + ks * 32);
        s0 = MFMA(k0f, qf[ks], s0);
        s1 = MFMA(k1f, qf[ks], s1);
      }
      if (MODE == 1) {
        const int dc = ab.c - kt;
        if (dc >= 3) {
          const float bv = aw.bias[256];
#pragma unroll
          for (int i = 0; i < 16; ++i) { s0[i] += bv; s1[i] += bv; }
        } else {
          const int base = 64 * dc + aw.qi0 + r + 128;
#pragma unroll
          for (int i = 0; i < 16; ++i) {
            const int ki = (i & 3) + 8 * (i >> 2) + 4 * h;
            int i0 = base - ki; i0 = i0 > 256 ? 256 : i0;
            int i1 = base - 32 - ki; i1 = i1 > 256 ? 256 : i1;
            s0[i] += aw.bias[i0];
            s1[i] += aw.bias[i1];
          }
        }
      }
      float mx = s0[0];
#pragma unroll
      for (int i = 1; i < 16; ++i) mx = fmaxf(mx, s0[i]);
#pragma unroll
      for (int i = 0; i < 16; ++i) mx = fmaxf(mx, s1[i]);
      mx = fmaxf(mx, __shfl_xor(mx, 32));
      const float mn = fmaxf(m, mx);
      const float al = fast_exp2(m - mn);
      m = mn;
      float ps = 0.f;
#pragma unroll
      for (int i = 0; i < 16; ++i) { s0[i] = fast_exp2(s0[i] - mn); ps += s0[i]; }
#pragma unroll
      for (int i = 0; i < 16; ++i) { s1[i] = fast_exp2(s1[i] - mn); ps += s1[i]; }
      l = l * al + ps;
#pragma unroll
      for (int i = 0; i < 16; ++i) { o0[i] *= al; o1[i] *= al; }
#pragma unroll
      for (int kb = 0; kb < 2; ++kb) {
#pragma unroll
        for (int s2 = 0; s2 < 2; ++s2) {
          u32x4 pw;
          if (kb == 0) pw = mk4(pack2(s0[8 * s2], s0[8 * s2 + 1]), pack2(s0[8 * s2 + 2], s0[8 * s2 + 3]), pack2(s0[8 * s2 + 4], s0[8 * s2 + 5]), pack2(s0[8 * s2 + 6], s0[8 * s2 + 7]));
          else pw = mk4(pack2(s1[8 * s2], s1[8 * s2 + 1]), pack2(s1[8 * s2 + 2], s1[8 * s2 + 3]), pack2(s1[8 * s2 + 4], s1[8 * s2 + 5]), pack2(s1[8 * s2 + 6], s1[8 * s2 + 7]));
          const bf16x8 pf = __builtin_bit_cast(bf16x8, pw);
          const char* a0 = vl + (kb * 32 + 16 * s2) * 2;
          {
            const u32x2 lo = *(const u32x2*)a0, hi = *(const u32x2*)(a0 + 16);
            const bf16x8 vf = __builtin_bit_cast(bf16x8, mk4(lo.x, lo.y, hi.x, hi.y));
            o0 = MFMA(vf, pf, o0);
          }
          {
            const u32x2 lo = *(const u32x2*)(a0 + 32 * 136), hi = *(const u32x2*)(a0 + 32 * 136 + 16);
            const bf16x8 vf = __builtin_bit_cast(bf16x8, mk4(lo.x, lo.y, hi.x, hi.y));
            o1 = MFMA(vf, pf, o1);
          }
        }
      }
    }
    __syncthreads();
    if (more) swrite();
    __syncthreads();
  }
  const float lt = l + __shfl_xor(l, 32);
  const float inv = 1.0f / lt;
#pragma unroll
  for (int db = 0; db < 2; ++db) {
#pragma unroll
    for (int g = 0; g < 4; ++g) {
      const int d0 = db * 32 + 8 * g + 4 * h;
      const u32x2 gv = *(const u32x2*)(aw.gate + (size_t)r * NP + d0);
      float v[4];
#pragma unroll
      for (int j = 0; j < 4; ++j) v[j] = (db == 0 ? o0[4 * g + j] : o1[4 * g + j]) * inv;
      v[0] *= silu_f(lo_f(gv.x)); v[1] *= silu_f(hi_f(gv.x));
      v[2] *= silu_f(lo_f(gv.y)); v[3] *= silu_f(hi_f(gv.y));
      *(u32x2*)(aw.out + (size_t)r * DM + d0) = mk2(pack2(v[0], v[1]), pack2(v[2], v[3]));
    }
  }
}

DI void phase_g1(const Params& p, int l, char* smem) {
  char* ws = p.ws;
  const u16* xb = (const u16*)(ws + OFF_XB);
  const u16* win = (const u16*)(ws + OFF_WIN) + (size_t)l * NP * DM;
  const int n_main = 256 * 23;
  const int n_tot = n_main + (l == 0 ? 256 : 0);
  for (int t = blockIdx.x; t < n_tot; t += gridDim.x) {
    Epi e{};
    if (t < n_main) {
      const int mt = t / 23, nt = t % 23;
      if (nt == 4 || nt == 5) {
        e.vt = (u16*)(ws + OFF_VTA); e.seq = SEQ; e.nseg0 = C_AV; e.hrows = 256;
        gemm_tile<M_TR>(xb, DM, win, DM, DM, mt * 256, nt * 128, e, smem);
      } else if (nt == 11) {
        e.vt = (u16*)(ws + OFF_VTC); e.seq = SEQ; e.nseg0 = C_CV; e.hrows = 128;
        gemm_tile<M_TR>(xb, DM, win, DM, DM, mt * 256, nt * 128, e, smem);
      } else {
        e.out = (u16*)(ws + OFF_PROJ); e.out_ld = NP;
        gemm_tile<M_ROW>(xb, DM, win, DM, DM, mt * 256, nt * 128, e, smem);
      }
    } else {
      const int u = t - n_main;
      const int ll = u >> 6, mt = (u >> 2) & 15, nt = u & 3;
      const u16* memb = (const u16*)(ws + OFF_MEMB);
      const u16* wm = (const u16*)(ws + OFF_WMKV) + (size_t)ll * 512 * 1024;
      if (nt < 2) {
        e.out = (u16*)(ws + OFF_KMEM) + (size_t)ll * 4096 * 256; e.out_ld = 256;
        gemm_tile<M_ROW>(memb, 1024, wm, 1024, 1024, mt * 256, nt * 128, e, smem);
      } else {
        e.vt = (u16*)(ws + OFF_VTMEM) + (size_t)ll * 4096 * 256; e.seq = 256; e.nseg0 = 256; e.hrows = 256;
        gemm_tile<M_TR>(memb, 1024, wm, 1024, 1024, mt * 256, nt * 128, e, smem);
      }
    }
  }
}

DI void phase_b1(const Params& p, int l, char* smem) {
  char* ws = p.ws;
  u16* proj = (u16*)(ws + OFF_PROJ);
  for (int t = blockIdx.x; t < 256 * 7; t += gridDim.x) {
    const int mt = t / 7, j = t % 7;
    const int m0 = mt * 256;
    Epi e{};
    __syncthreads();
    if (j < 3) {
      compute_rs(proj, m0, C_BCQ, 192, smem);
      __syncthreads();
      e.out = (u16*)(ws + OFF_QB); e.c32 = (const float*)(ws + OFF_COS32); e.s32 = (const float*)(ws + OFF_SIN32);
      gemm_tile<M_UQ>(proj + C_BCQ, NP, (const u16*)(ws + OFF_WUQ) + (size_t)l * 384 * 192, 192, 192, m0, j * 128, e, smem);
    } else {
      compute_rs(proj, m0, C_BCKV, 128, smem);
      __syncthreads();
      const u16* w = (const u16*)(ws + OFF_WUKV) + (size_t)l * 512 * 128;
      const int nt = j - 3;
      if (nt < 2) {
        e.out = (u16*)(ws + OFF_KB);
        gemm_tile<M_UKVK>(proj + C_BCKV, NP, w, 128, 128, m0, nt * 128, e, smem);
      } else {
        e.vt = (u16*)(ws + OFF_VTB); e.seq = SEQ; e.nseg0 = 256; e.hrows = 256;
        gemm_tile<M_UKVV>(proj + C_BCKV, NP, w, 128, 128, m0, nt * 128, e, smem);
      }
    }
  }
  const size_t gtid = (size_t)blockIdx.x * 256 + opaque_tid();
  const size_t gn = (size_t)gridDim.x * 256;
  const float* c64 = (const float*)(ws + OFF_COS64); const float* s64 = (const float*)(ws + OFF_SIN64);
  const float* c32 = (const float*)(ws + OFF_COS32); const float* s32 = (const float*)(ws + OFF_SIN32);
  for (size_t i = gtid; i < (size_t)T_TOK * 24; i += gn) {
    const int tok = (int)(i / 24), u = (int)(i % 24);
    const int slot = u >> 2, c = u & 3;
    const int col0 = (slot < 4) ? (C_CQ + slot * 64) : (C_CK + (slot - 4) * 64);
    u16* p1 = proj + (size_t)tok * NP + col0 + 8 * c;
    const u32x4 a = *(const u32x4*)p1, b = *(const u32x4*)(p1 + 32);
    const f32x4 ca = *(const f32x4*)(c64 + (size_t)tok * 32 + 8 * c), cb = *(const f32x4*)(c64 + (size_t)tok * 32 + 8 * c + 4);
    const f32x4 sa = *(const f32x4*)(s64 + (size_t)tok * 32 + 8 * c), sb = *(const f32x4*)(s64 + (size_t)tok * 32 + 8 * c + 4);
    const float cs[8] = {ca.x, ca.y, ca.z, ca.w, cb.x, cb.y, cb.z, cb.w};
    const float sn[8] = {sa.x, sa.y, sa.z, sa.w, sb.x, sb.y, sb.z, sb.w};
    const unsigned aw_[4] = {a.x, a.y, a.z, a.w}, bw_[4] = {b.x, b.y, b.z, b.w};
    unsigned o1[4], o2[4];
#pragma unroll
    for (int j = 0; j < 4; ++j) {
      const float x1a = lo_f(aw_[j]), x1b = hi_f(aw_[j]), x2a = lo_f(bw_[j]), x2b = hi_f(bw_[j]);
      o1[j] = pack2(x1a * cs[2 * j] - x2a * sn[2 * j], x1b * cs[2 * j + 1] - x2b * sn[2 * j + 1]);
      o2[j] = pack2(x2a * cs[2 * j] + x1a * sn[2 * j], x2b * cs[2 * j + 1] + x1b * sn[2 * j + 1]);
    }
    *(u32x4*)p1 = mk4(o1[0], o1[1], o1[2], o1[3]);
    *(u32x4*)(p1 + 32) = mk4(o2[0], o2[1], o2[2], o2[3]);
  }
  u16* kB = (u16*)(ws + OFF_KB);
  for (size_t i = gtid; i < (size_t)T_TOK * 2; i += gn) {
    const int tok = (int)(i >> 1), c = (int)(i & 1);
    const u16* p1 = proj + (size_t)tok * NP + C_BKR + 8 * c;
    const u32x4 a = *(const u32x4*)p1, b = *(const u32x4*)(p1 + 16);
    const f32x4 ca = *(const f32x4*)(c32 + (size_t)tok * 16 + 8 * c), cb = *(const f32x4*)(c32 + (size_t)tok * 16 + 8 * c + 4);
    const f32x4 sa = *(const f32x4*)(s32 + (size_t)tok * 16 + 8 * c), sb = *(const f32x4*)(s32 + (size_t)tok * 16 + 8 * c + 4);
    const float cs[8] = {ca.x, ca.y, ca.z, ca.w, cb.x, cb.y, cb.z, cb.w};
    const float sn[8] = {sa.x, sa.y, sa.z, sa.w, sb.x, sb.y, sb.z, sb.w};
    const unsigned aw_[4] = {a.x, a.y, a.z, a.w}, bw_[4] = {b.x, b.y, b.z, b.w};
    unsigned o1[4], o2[4];
#pragma unroll
    for (int j = 0; j < 4; ++j) {
      const float x1a = lo_f(aw_[j]), x1b = hi_f(aw_[j]), x2a = lo_f(bw_[j]), x2b = hi_f(bw_[j]);
      o1[j] = pack2(x1a * cs[2 * j] - x2a * sn[2 * j], x1b * cs[2 * j + 1] - x2b * sn[2 * j + 1]);
      o2[j] = pack2(x2a * cs[2 * j] + x1a * sn[2 * j], x2b * cs[2 * j + 1] + x1b * sn[2 * j + 1]);
    }
#pragma unroll
    for (int hh = 0; hh < 4; ++hh) {
      u16* d = kB + (size_t)tok * 384 + hh * 96 + 64 + 8 * c;
      *(u32x4*)d = mk4(o1[0], o1[1], o1[2], o1[3]);
      *(u32x4*)(d + 16) = mk4(o2[0], o2[1], o2[2], o2[3]);
    }
  }
}

DI void phase_att(const Params& p, int l, char* smem) {
  char* ws = p.ws;
  const int tid = opaque_tid(), wave = tid >> 6;
  const u16* proj = (const u16*)(ws + OFF_PROJ);
  u16* gated = (u16*)(ws + OFF_GATED);
  float* biasl = (float*)(smem + SM_BIAS);
  int* s_item = (int*)(smem + SM_ITEM);
  int* ctr = (int*)(ws + OFF_CTR) + l;
  for (int i = tid; i < 4 * 257; i += 256) biasl[i] = p.rel_bias[(size_t)l * 4 * 257 + i] * LOG2E;
  __syncthreads();
  const int NITEM = 2048;
  for (;;) {
    __syncthreads();
    if (tid == 0) *s_item = atomicAdd(ctr, 1);
    __syncthreads();
    const int item = *s_item;
    if (item >= 4 * NITEM) break;
    AttnBlk ab{}; AttnWave aw{};
    aw.m_init = -1e30f; aw.l_init = 0.f;
    if (item < NITEM) {
      const int qb = 31 - (item >> 6), b = (item >> 2) & 15, hh = item & 3;
      const size_t tok0 = (size_t)b * SEQ + qb * 128 + wave * 32;
      ab.k = (const u16*)(ws + OFF_KB) + (size_t)b * SEQ * 384 + hh * 96; ab.k_ld = 384;
      ab.vt = (const u16*)(ws + OFF_VTB) + ((size_t)b * 256 + hh * 64) * SEQ; ab.vt_ld = SEQ;
      ab.kt_begin = 0; ab.kt_end = 2 * qb + 2; ab.c = 0;
      aw.q = (const u16*)(ws + OFF_QB) + tok0 * 384 + hh * 96; aw.q_ld = 384;
      aw.gate = proj + tok0 * NP + C_BG + hh * 64;
      aw.out = gated + tok0 * DM + 256 + hh * 64;
      aw.hoff = 0; aw.my_kt_end = 2 * qb + 1 + (wave >> 1);
      attn_item<96, 1, 0>(ab, aw, smem);
    } else if (item < 2 * NITEM) {
      const int it = item - NITEM;
      const int c = 63 - (it >> 5), b = (it >> 1) & 15, hp = it & 1;
      const int head = 2 * hp + (wave >> 1);
      const size_t tok0 = (size_t)b * SEQ + c * 64 + (wave & 1) * 32;
      ab.k = proj + (size_t)b * SEQ * NP + C_AK + hp * 128; ab.k_ld = NP;
      ab.vt = (const u16*)(ws + OFF_VTA) + ((size_t)b * 256 + hp * 128) * SEQ; ab.vt_ld = SEQ;
      ab.kt_begin = c - 8 < 0 ? 0 : c - 8; ab.kt_end = c + 1; ab.c = c;
      aw.q = proj + tok0 * NP + C_AQ + head * 64; aw.q_ld = NP;
      aw.gate = proj + tok0 * NP + C_AG + head * 64;
      aw.out = gated + tok0 * DM + head * 64;
      aw.hoff = wave >> 1; aw.my_kt_end = c + 1;
      aw.bias = biasl + head * 257; aw.qi0 = (wave & 1) * 32;
      attn_item<64, 2, 1>(ab, aw, smem);
    } else if (item < 3 * NITEM) {
      const int it = item - 2 * NITEM;
      const int c = it >> 5, b = (it >> 1) & 15, hp = it & 1;
      const int head = 2 * hp + (wave >> 1);
      const size_t tok0 = (size_t)b * SEQ + c * 64 + (wave & 1) * 32;
      ab.k = (const u16*)(ws + OFF_KMEM) + ((size_t)l * 4096 + b * 256) * 256 + hp * 128; ab.k_ld = 256;
      ab.vt = (const u16*)(ws + OFF_VTMEM) + ((size_t)l * 4096 + b * 256 + hp * 128) * 256; ab.vt_ld = 256;
      ab.kt_begin = 0; ab.kt_end = 4; ab.c = 0;
      aw.q = proj + tok0 * NP + C_MQ + head * 64; aw.q_ld = NP;
      aw.gate = proj + tok0 * NP + C_MG + head * 64;
      aw.out = gated + tok0 * DM + 768 + head * 64;
      aw.hoff = wave >> 1; aw.my_kt_end = 4;
      attn_item<64, 2, 0>(ab, aw, smem);
    } else {
      const int it = item - 3 * NITEM;
      const int c = it >> 5, b = (it >> 1) & 15, kvh = it & 1;
      const int head = 2 * kvh + (wave >> 1);
      const size_t tok0 = (size_t)b * SEQ + c * 64 + (wave & 1) * 32;
      ab.k = proj + (size_t)b * SEQ * NP + C_CK + kvh * 64; ab.k_ld = NP;
      ab.vt = (const u16*)(ws + OFF_VTC) + ((size_t)b * 128 + kvh * 64) * SEQ; ab.vt_ld = SEQ;
      ab.kt_begin = c - 2 < 0 ? 0 : c - 2; ab.kt_end = c + 1; ab.c = c;
      aw.q = proj + tok0 * NP + C_CQ + head * 64; aw.q_ld = NP;
      aw.gate = proj + tok0 * NP + C_CG + head * 64;
      aw.out = gated + tok0 * DM + 512 + head * 64;
      aw.hoff = 0; aw.my_kt_end = c + 1;
      aw.m_init = p.sinks[l * 4 + head] * LOG2E;
      aw.l_init = ((tid & 63) < 32) ? 1.0f : 0.0f;
      attn_item<64, 1, 2>(ab, aw, smem);
    }
  }
}

DI void phase_g3(const Params& p, int l, char* smem) {
  char* ws = p.ws;
  const u16* gated = (const u16*)(ws + OFF_GATED);
  const u16* wout = (const u16*)(ws + OFF_WOUT) + (size_t)l * DM * DM;
  for (int t = blockIdx.x; t < 256 * 8; t += gridDim.x) {
    const int mt = t >> 3, nt = t & 7;
    Epi e{};
    e.xprev = (l == 0) ? p.x : p.out; e.xout = p.out;
    gemm_tile<M_G3>(gated, DM, wout, DM, DM, mt * 256, nt * 128, e, smem);
  }
}

DI void phase_ln(const Params& p, int l) {
  char* ws = p.ws;
  u16* xb = (u16*)(ws + OFF_XB);
  const int tid = opaque_tid();
  const int lane = tid & 63;
  const int gw = blockIdx.x * 4 + (tid >> 6), nw = gridDim.x * 4;
  const float* g = p.ln_g + l * DM; const float* bb = p.ln_b + l * DM;
  f32x4 gv[4], bv[4];
#pragma unroll
  for (int i = 0; i < 4; ++i) { gv[i] = *(const f32x4*)(g + i * 256 + lane * 4); bv[i] = *(const f32x4*)(bb + i * 256 + lane * 4); }
  for (int row = gw; row < T_TOK; row += nw) {
    float* rp = p.out + (size_t)row * DM;
    f32x4 v[4];
#pragma unroll
    for (int i = 0; i < 4; ++i) v[i] = *(const f32x4*)(rp + i * 256 + lane * 4);
    float s = 0.f;
#pragma unroll
    for (int i = 0; i < 4; ++i) s += v[i].x + v[i].y + v[i].z + v[i].w;
#pragma unroll
    for (int o = 32; o >= 1; o >>= 1) s += __shfl_xor(s, o);
    const float mu = s * (1.0f / 1024.0f);
    float q = 0.f;
#pragma unroll
    for (int i = 0; i < 4; ++i) {
      v[i].x -= mu; v[i].y -= mu; v[i].z -= mu; v[i].w -= mu;
      q += v[i].x * v[i].x + v[i].y * v[i].y + v[i].z * v[i].z + v[i].w * v[i].w;
    }
#pragma unroll
    for (int o = 32; o >= 1; o >>= 1) q += __shfl_xor(q, o);
    const float rstd = rsqrtf(q * (1.0f / 1024.0f) + 1e-5f);
#pragma unroll
    for (int i = 0; i < 4; ++i) {
      f32x4 y;
      y.x = v[i].x * rstd * gv[i].x + bv[i].x;
      y.y = v[i].y * rstd * gv[i].y + bv[i].y;
      y.z = v[i].z * rstd * gv[i].z + bv[i].z;
      y.w = v[i].w * rstd * gv[i].w + bv[i].w;
      *(f32x4*)(rp + i * 256 + lane * 4) = y;
      if (l + 1 < DEPTH) *(u32x2*)(xb + (size_t)row * DM + i * 256 + lane * 4) = mk2(pack2(y.x, y.y), pack2(y.z, y.w));
    }
  }
}

__global__ void __launch_bounds__(256, 2) fwd_megakernel(Params p) {
  cg::grid_group grid = cg::this_grid();
  __shared__ __attribute__((aligned(16))) char smem[SM_TOTAL];
  phase0(p, smem);
  grid.sync();
  for (int l = 0; l < DEPTH; ++l) {
    phase_g1(p, l, smem);
    grid.sync();
    phase_b1(p, l, smem);
    grid.sync();
    phase_att(p, l, smem);
    grid.sync();
    phase_g3(p, l, smem);
    grid.sync();
    phase_ln(p, l);
    if (l + 1 < DEPTH) grid.sync();
  }
}

extern "C" void kernel_launch(void* const* d_in, const int* in_sizes, int n_in, void* d_out,
                              int out_size, void* d_ws, size_t ws_size, hipStream_t stream) {
  static int grid_blocks = 0;
  if (!grid_blocks) {
    int dev = 0, cus = 0, per_cu = 0;
    (void)hipGetDevice(&dev);
    (void)hipDeviceGetAttribute(&cus, hipDeviceAttributeMultiprocessorCount, dev);
    (void)hipOccupancyMaxActiveBlocksPerMultiprocessor(&per_cu, fwd_megakernel, 256, 0);
    if (per_cu > 2) per_cu = 2;
    if (per_cu < 1) per_cu = 1;
    grid_blocks = cus * per_cu;
  }
  if (ws_size < WS_NEEDED) { fprintf(stderr, "workspace too small: %zu < %zu\n", ws_size, (size_t)WS_NEEDED); return; }
  Params p{};
  p.x = (const float*)d_in[0]; p.mem = (const float*)d_in[1]; p.pos = (const int*)d_in[2];
  p.w_in = (const float*)d_in[3]; p.rel_bias = (const float*)d_in[4]; p.q_norm = (const float*)d_in[5];
  p.w_uq = (const float*)d_in[6]; p.kv_norm = (const float*)d_in[7]; p.w_ukv = (const float*)d_in[8];
  p.sinks = (const float*)d_in[9]; p.w_mem_kv = (const float*)d_in[10]; p.w_out = (const float*)d_in[11];
  p.ln_g = (const float*)d_in[12]; p.ln_b = (const float*)d_in[13];
  p.out = (float*)d_out; p.ws = (char*)d_ws;
  void* args[] = {&p};
  hipError_t e = hipLaunchCooperativeKernel((void*)fwd_megakernel, dim3(grid_blocks), dim3(256), args, 0, stream);
  if (e != hipSuccess) fprintf(stderr, "cooperative launch failed: %s (grid %d)\n", hipGetErrorString(e), grid_blocks);
}
```

```cpp
#include <hip/hip_runtime.h>
#include <hip/hip_cooperative_groups.h>
#include <cstdio>
#include <type_traits>
namespace cg = cooperative_groups;

typedef unsigned short u16;
typedef short bf16x8 __attribute__((ext_vector_type(8)));
typedef float f32x16 __attribute__((ext_vector_type(16)));
typedef __bf16 bf16x2_t __attribute__((ext_vector_type(2)));
typedef float f32x2_t __attribute__((ext_vector_type(2)));
typedef unsigned u32x4 __attribute__((ext_vector_type(4)));
typedef unsigned u32x2 __attribute__((ext_vector_type(2)));
typedef float f32x4 __attribute__((ext_vector_type(4)));

#define DI __device__ __forceinline__
#define MFMA(a, b, c) __builtin_amdgcn_mfma_f32_32x32x16_bf16((a), (b), (c), 0, 0, 0)

constexpr int T_TOK = 65536;
constexpr int SEQ = 4096;
constexpr int NBATCH = 16;
constexpr int DM = 1024;
constexpr int NP = 3072;
constexpr int PW = 2912;
constexpr int DEPTH = 4;
constexpr int NTHR = 512;
constexpr int C_AQ = 0, C_AK = 256, C_AV = 512, C_AG = 768;
constexpr int C_CQ = 1024, C_CK = 1280, C_CV = 1408, C_CG = 1536;
constexpr int C_MQ = 1792, C_MG = 2048;
constexpr int C_BG = 2304, C_BCQ = 2560, C_BCKV = 2752, C_BKR = 2880;

constexpr float LOG2E = 1.4426950408889634f;
constexpr float QS64 = 0.125f * LOG2E;
constexpr float QS96 = 0.10206207261596575f * LOG2E;

constexpr size_t AL(size_t x) { return (x + 255) & ~(size_t)255; }
constexpr size_t OFF_WIN = 0;
constexpr size_t OFF_WOUT = OFF_WIN + AL((size_t)DEPTH * NP * DM * 2);
constexpr size_t OFF_WUQ = OFF_WOUT + AL((size_t)DEPTH * DM * DM * 2);
constexpr size_t OFF_WUKV = OFF_WUQ + AL((size_t)DEPTH * 384 * 192 * 2);
constexpr size_t OFF_WMKV = OFF_WUKV + AL((size_t)DEPTH * 512 * 128 * 2);
constexpr size_t OFF_MEMB = OFF_WMKV + AL((size_t)DEPTH * 512 * 1024 * 2);
constexpr size_t OFF_KVMEM = OFF_MEMB + AL((size_t)4096 * 1024 * 2);
constexpr size_t OFF_VTMEM = OFF_KVMEM + AL((size_t)4096 * 2048 * 2);
constexpr size_t OFF_COS64 = OFF_VTMEM + AL((size_t)DEPTH * 4096 * 256 * 2);
constexpr size_t OFF_SIN64 = OFF_COS64 + AL((size_t)T_TOK * 32 * 4);
constexpr size_t OFF_COS32 = OFF_SIN64 + AL((size_t)T_TOK * 32 * 4);
constexpr size_t OFF_SIN32 = OFF_COS32 + AL((size_t)T_TOK * 16 * 4);
constexpr size_t OFF_XB = OFF_SIN32 + AL((size_t)T_TOK * 16 * 4);
constexpr size_t OFF_PROJ = OFF_XB + AL((size_t)T_TOK * DM * 2);
constexpr size_t OFF_VTA = OFF_PROJ + AL((size_t)T_TOK * NP * 2);
constexpr size_t OFF_VTC = OFF_VTA + AL((size_t)T_TOK * 256 * 2);
constexpr size_t OFF_VTB = OFF_VTC + AL((size_t)T_TOK * 128 * 2);
constexpr size_t OFF_QB = OFF_VTB + AL((size_t)T_TOK * 256 * 2);
constexpr size_t OFF_KB = OFF_QB + AL((size_t)T_TOK * 384 * 2);
constexpr size_t OFF_GATED = OFF_KB + AL((size_t)T_TOK * 384 * 2);
constexpr size_t OFF_STATS = OFF_GATED + AL((size_t)T_TOK * DM * 2);
constexpr size_t OFF_BAR = OFF_STATS + AL((size_t)T_TOK * 2 * 4);
constexpr size_t BAR_BYTES = 3456 * 4;
constexpr size_t OFF_WQ = OFF_BAR + AL(BAR_BYTES);
constexpr size_t WQ_BYTES = (size_t)DEPTH * 4 * 8 * 64;
constexpr size_t ZERO_BYTES = (OFF_WQ + WQ_BYTES) - OFF_BAR;
constexpr size_t WS_NEEDED = OFF_WQ + WQ_BYTES;

constexpr int SM_STAGE_BYTES = 131072;
constexpr int GROW = 40;
constexpr int G_STAGE = 384 * GROW * 2;
constexpr int HALF_GEMM = 2 * G_STAGE;
constexpr int VROWB = 144;
constexpr int ATT_STAGE = 17408 + 128 * VROWB;
constexpr int HALF_ATT = 2 * ATT_STAGE;
constexpr int SM_K = 0;
constexpr int SM_VT = 17408;
constexpr int SM_BIAS = 2 * HALF_ATT;
constexpr int SM_RS = SM_BIAS + 4128;
constexpr int SM_XB = SM_RS + 2048;
constexpr int SM_ITEM = SM_XB + 16;
constexpr int SM_TOTAL = SM_ITEM + 16;

struct Params {
  const float* x; const float* mem; const int* pos;
  const float* w_in; const float* rel_bias; const float* q_norm; const float* w_uq;
  const float* kv_norm; const float* w_ukv; const float* sinks; const float* w_mem_kv;
  const float* w_out; const float* ln_g; const float* ln_b;
  float* out; char* ws;
  int use_cg_sync; int pad_;
};

DI float bf2f(u16 v) { return __uint_as_float(((unsigned)v) << 16); }
DI unsigned pack2(float a, float b) {
  f32x2_t v = {a, b};
  bf16x2_t r = __builtin_convertvector(v, bf16x2_t);
  return __builtin_bit_cast(unsigned, r);
}
DI u32x4 mk4(unsigned a, unsigned b, unsigned c, unsigned d) { u32x4 v = {a, b, c, d}; return v; }
DI u32x2 mk2(unsigned a, unsigned b) { u32x2 v = {a, b}; return v; }
DI int opaque_tid() { int t = threadIdx.x; asm volatile("" : "+v"(t)); return t; }
typedef const __attribute__((address_space(1))) char* gptr_t;
DI gptr_t uniform_ptr(const void* p) {
  const unsigned long long v = (unsigned long long)p;
  const unsigned lo = __builtin_amdgcn_readfirstlane((unsigned)v), hi = __builtin_amdgcn_readfirstlane((unsigned)(v >> 32));
  return (gptr_t)(((unsigned long long)hi << 32) | lo);
}
DI float lo_f(unsigned u) { return __uint_as_float(u << 16); }
DI float hi_f(unsigned u) { return __uint_as_float(u & 0xffff0000u); }
DI float fast_exp2(float x) { return __builtin_amdgcn_exp2f(x); }
DI float silu_f(float g) { return g * __builtin_amdgcn_rcpf(1.0f + fast_exp2(-g * LOG2E)); }

DI int win_colmap(int n, float& sc) {
  sc = 1.0f;
  if (n < 1024) { if (n < 256) sc = QS64; return n; }
  if (n < 1280) { sc = QS64; return 1632 + (n - 1024); }
  if (n < 1408) return 1888 + (n - 1280);
  if (n < 1536) return 2016 + (n - 1408);
  if (n < 1792) return 2144 + (n - 1536);
  if (n < 2048) { sc = QS64; return 2400 + (n - 1792); }
  if (n < 2304) return 2656 + (n - 2048);
  if (n < 2560) return 1376 + (n - 2304);
  if (n < 2752) return 1024 + (n - 2560);
  if (n < 2880) return 1216 + (n - 2752);
  if (n < 2912) return 1344 + (n - 2880);
  sc = 0.0f; return 0;
}

DI void transpose_tile(const Params& p, int l, int job, int kt, int nt, float* tile, int tid) {
  const float* src; int lds_; u16* dst; int ldd; const float* kscale = nullptr; float kconst = 1.0f;
  char* ws = p.ws;
  if (job == 0) { src = p.w_in + (size_t)l * DM * PW; lds_ = PW; dst = (u16*)(ws + OFF_WIN) + (size_t)l * NP * DM; ldd = DM; }
  else if (job == 1) { src = p.w_out + (size_t)l * DM * DM; lds_ = DM; dst = (u16*)(ws + OFF_WOUT) + (size_t)l * DM * DM; ldd = DM; }
  else if (job == 2) { src = p.w_uq + (size_t)l * 192 * 384; lds_ = 384; dst = (u16*)(ws + OFF_WUQ) + (size_t)l * 384 * 192; ldd = 192; kscale = p.q_norm + l * 192; kconst = QS96; }
  else if (job == 3) { src = p.w_ukv + (size_t)l * 128 * 512; lds_ = 512; dst = (u16*)(ws + OFF_WUKV) + (size_t)l * 512 * 128; ldd = 128; kscale = p.kv_norm + l * 128; }
  else { src = p.w_mem_kv + (size_t)l * 1024 * 512; lds_ = 512; dst = (u16*)(ws + OFF_WMKV) + (size_t)l * 512 * 1024; ldd = 1024; }
  const int k0 = kt * 64, n0 = nt * 64;
  {
    const int nx = tid & 63;
    const int n = n0 + nx;
    int col; float sc = 1.0f;
    if (job == 0) col = win_colmap(n, sc);
    else if (job == 2) col = (n < 256) ? ((n >> 6) * 96 + (n & 63)) : (((n - 256) >> 5) * 96 + 64 + ((n - 256) & 31));
    else if (job == 3) col = (n < 256) ? ((n >> 6) * 128 + (n & 63)) : (((n - 256) >> 6) * 128 + 64 + ((n - 256) & 63));
    else col = n;
    sc *= kconst;
    float v[16];
#pragma unroll
    for (int i = 0; i < 16; ++i) v[i] = __builtin_nontemporal_load(&src[(size_t)(k0 + i * 4 + (tid >> 6)) * lds_ + col]);
#pragma unroll
    for (int i = 0; i < 16; ++i) {
      const int ky = i * 4 + (tid >> 6);
      float x = v[i] * sc;
      if (kscale) x *= kscale[k0 + ky];
      tile[ky * 65 + nx] = x;
    }
  }
  __syncthreads();
  {
    const int n = tid >> 2, kc = (tid & 3) * 16;
    unsigned w[8];
#pragma unroll
    for (int i = 0; i < 8; ++i) w[i] = pack2(tile[(kc + 2 * i) * 65 + n], tile[(kc + 2 * i + 1) * 65 + n]);
    u32x4* d = (u32x4*)(dst + (size_t)(n0 + n) * ldd + k0 + kc);
    d[0] = mk4(w[0], w[1], w[2], w[3]);
    d[1] = mk4(w[4], w[5], w[6], w[7]);
  }
  __syncthreads();
}

DI void sincos_reduced(double ang, float& c, float& s) {
  const double TWO_PI = 6.283185307179586476925287;
  double k = rint(ang * (1.0 / TWO_PI));
  double r = fma(-k, TWO_PI, ang);
  double r2 = r * r;
  double sp = -1.0 / 15511210043330985984000000.0;
  double ss = 1.0 / 15511210043330985984000000.0;
  ss = fma(ss, r2, -1.0 / 25852016738884976640000.0);
  ss = fma(ss, r2, 1.0 / 51090942171709440000.0);
  ss = fma(ss, r2, -1.0 / 121645100408832000.0);
  ss = fma(ss, r2, 1.0 / 355687428096000.0);
  ss = fma(ss, r2, -1.0 / 1307674368000.0);
  ss = fma(ss, r2, 1.0 / 6227020800.0);
  ss = fma(ss, r2, -1.0 / 39916800.0);
  ss = fma(ss, r2, 1.0 / 362880.0);
  ss = fma(ss, r2, -1.0 / 5040.0);
  ss = fma(ss, r2, 1.0 / 120.0);
  ss = fma(ss, r2, -1.0 / 6.0);
  ss = fma(ss, r2, 1.0);
  ss *= r;
  (void)sp;
  double cc = 1.0 / 620448401733239439360000.0;
  cc = fma(cc, r2, -1.0 / 1124000727777607680000.0);
  cc = fma(cc, r2, 1.0 / 2432902008176640000.0);
  cc = fma(cc, r2, -1.0 / 6402373705728000.0);
  cc = fma(cc, r2, 1.0 / 20922789888000.0);
  cc = fma(cc, r2, -1.0 / 87178291200.0);
  cc = fma(cc, r2, 1.0 / 479001600.0);
  cc = fma(cc, r2, -1.0 / 3628800.0);
  cc = fma(cc, r2, 1.0 / 40320.0);
  cc = fma(cc, r2, -1.0 / 720.0);
  cc = fma(cc, r2, 1.0 / 24.0);
  cc = fma(cc, r2, -0.5);
  cc = fma(cc, r2, 1.0);
  c = (float)cc; s = (float)ss;
}

DI void phase0(const Params& p, char* smem) {
  const int tid = opaque_tid();
  const size_t gtid = (size_t)blockIdx.x * NTHR + tid;
  const size_t gn = (size_t)gridDim.x * NTHR;
  char* ws = p.ws;
  {
    u16* xb = (u16*)(ws + OFF_XB);
    const size_t n8 = (size_t)T_TOK * DM / 8;
    for (size_t i = gtid; i < n8; i += 4 * gn) {
      f32x4 a[4], b[4];
#pragma unroll
      for (int u = 0; u < 4; ++u) { const size_t k = (i + u * gn < n8) ? i + u * gn : i; a[u] = __builtin_nontemporal_load(&((const f32x4*)p.x)[2 * k]); b[u] = __builtin_nontemporal_load(&((const f32x4*)p.x)[2 * k + 1]); }
#pragma unroll
      for (int u = 0; u < 4; ++u) { const size_t k = (i + u * gn < n8) ? i + u * gn : i; ((u32x4*)xb)[k] = mk4(pack2(a[u].x, a[u].y), pack2(a[u].z, a[u].w), pack2(b[u].x, b[u].y), pack2(b[u].z, b[u].w)); }
    }
    u16* mb = (u16*)(ws + OFF_MEMB);
    const size_t m8 = (size_t)4096 * 1024 / 8;
    for (size_t i = gtid; i < m8; i += gn) {
      const f32x4 a = ((const f32x4*)p.mem)[2 * i], b = ((const f32x4*)p.mem)[2 * i + 1];
      ((u32x4*)mb)[i] = mk4(pack2(a.x, a.y), pack2(a.z, a.w), pack2(b.x, b.y), pack2(b.z, b.w));
    }
  }
  {
    float* c64 = (float*)(ws + OFF_COS64); float* s64 = (float*)(ws + OFF_SIN64);
    float* c32 = (float*)(ws + OFF_COS32); float* s32 = (float*)(ws + OFF_SIN32);
    const double L2T = 13.287712379549449;
    float* invf = (float*)(smem + 40960);
    if (tid < 48) invf[tid] = (tid < 32) ? (float)exp2(-(double)(2 * tid) / 64.0 * L2T) : (float)exp2(-(double)(2 * (tid - 32)) / 32.0 * L2T);
    __syncthreads();
    for (size_t i = gtid; i < (size_t)T_TOK * 48; i += gn) {
      const int tok = (int)(i / 48), j = (int)(i % 48);
      const float angf = (float)p.pos[tok] * invf[j];
      float c, s;
      sincos_reduced((double)angf, c, s);
      if (j < 32) { c64[(size_t)tok * 32 + j] = c; s64[(size_t)tok * 32 + j] = s; }
      else { c32[(size_t)tok * 16 + (j - 32)] = c; s32[(size_t)tok * 16 + (j - 32)] = s; }
    }
    __syncthreads();
  }
  {
    const int hf = tid >> 8, tidh = tid & 255;
    float* tile = (float*)(smem + hf * 16896);
    for (int t2 = blockIdx.x; t2 < DEPTH * 1186 / 2; t2 += gridDim.x) {
      const int t = 2 * t2 + hf;
      const int l = t / 1186; int u = t % 1186;
      int job, kt, nt;
      if (u < 768) { job = 0; kt = u / 48; nt = u % 48; }
      else if ((u -= 768) < 256) { job = 1; kt = u / 16; nt = u % 16; }
      else if ((u -= 256) < 18) { job = 2; kt = u / 6; nt = u % 6; }
      else if ((u -= 18) < 16) { job = 3; kt = u / 8; nt = u % 8; }
      else { u -= 16; job = 4; kt = u / 8; nt = u % 8; }
      transpose_tile(p, l, job, kt, nt, tile, tidh);
    }
  }
}

namespace pg8 {
#define PG8_LAS __attribute__((address_space(3)))
typedef unsigned short bf16_t;
typedef short bf16x8 __attribute__((ext_vector_type(8)));
typedef float f32x4 __attribute__((ext_vector_type(4)));
typedef unsigned u32x4 __attribute__((ext_vector_type(4)));
constexpr int BM = 256, BK = 64, HALF = 128, HTB = HALF * BK * 2  , STAGE_BYTES = 8 * HTB, NXCD = 8, WGM = 8;

__host__ __device__ __forceinline__ int lds_byte(int r, int c) { const int st = (r >> 4) * 2 + (c >> 5), rr = r & 15, cc = c & 31, ob = rr * 64 + cc * 2; return st * 1024 + (ob ^ (((ob >> 9) & 1) << 5)); }
__host__ __device__ __forceinline__ void stage_rc(int b, int& R, int& C) { const int st = b / 1024, sb = b % 1024, swz = sb ^ (((sb >> 9) & 1) << 5); R = (st >> 1) * 16 + swz / 64; C = (st & 1) * 32 + (swz % 64) / 2; }
__host__ __device__ __forceinline__ int perm32(int rho) { const int n = rho >> 4, i = rho & 15; return 8 * (i >> 2) + 4 * n + (i & 3); }

typedef PG8_LAS unsigned char* PG8_LAS_T;
struct Unit { int pm, pn; };
struct Gemm { const bf16_t* A; const bf16_t* Bt; int M, N, K; };

struct StaticOrder {
    int nM, nN, nwg, G, c;
    __host__ __device__ void init(int M, int N, int G_, int c_) { nM = M / BM; nN = N / BM; nwg = nM * nN; G = G_; c = c_; }
    __host__ __device__ bool next(int i, Unit& u) const {
        const long L = (long)i * G + c; if (L >= nwg) return false;
        int wgid = (int)L; { const int q = nwg / NXCD, r = nwg % NXCD, xcd = wgid % NXCD, off = wgid / NXCD; wgid = (xcd < r ? xcd * (q + 1) : r * (q + 1) + (xcd - r) * q) + off; }
        const int nig = WGM * nN, gid = wgid / nig, fm = gid * WGM, gsz = (nM - fm) < WGM ? (nM - fm) : WGM;
        u.pm = fm + ((wgid % nig) % gsz); u.pn = (wgid % nig) / gsz; return true;
    }
    __device__ __forceinline__ void a_ready(const Unit&) const {}
    __device__ __forceinline__ void done(const Unit&) const {}
};
__device__ __forceinline__ unsigned cvt_pk_bf16(float lo, float hi) { unsigned r; asm volatile("v_cvt_pk_bf16_f32 %0, %1, %2" : "=v"(r) : "v"(lo), "v"(hi)); return r; }

struct EpiBf16 {
    static constexpr bool PERM = true, AFTER_DRAIN = false;
    bf16_t* O; int ldc; int nt;
    __device__ __forceinline__ void operator()(const f32x4 (&acc)[2][2][4][2], const Unit& u, int wr, int wc, int fr, int fq) const {
        const int row0 = u.pm * BM + wr * 64 + fr; const int col0 = u.pn * BM + wc * 32 + 8 * fq;
#pragma unroll
        for (int ai = 0; ai < 2; ++ai)
#pragma unroll
            for (int m = 0; m < 4; ++m) { bf16_t* rowp = O + (size_t)(row0 + ai * HALF + m * 16) * ldc + col0;
#pragma unroll
                for (int bj = 0; bj < 2; ++bj) { const f32x4 v0 = acc[ai][bj][m][0], v1 = acc[ai][bj][m][1];
                    u32x4 w; w.x = cvt_pk_bf16(v0[0], v0[1]); w.y = cvt_pk_bf16(v0[2], v0[3]); w.z = cvt_pk_bf16(v1[0], v1[1]); w.w = cvt_pk_bf16(v1[2], v1[3]);
                    if (nt) __builtin_nontemporal_store(w, (u32x4*)(rowp + bj * HALF)); else *(u32x4*)(rowp + bj * HALF) = w; } }
    }
};
template <bool LN> struct EpiRes {
    static constexpr bool PERM = false, AFTER_DRAIN = false;
    static constexpr float alpha = 1.681792830507429f;
    const float* base; float* out; int ldc; const float* stats; const float* g; const float* b;
    __device__ __forceinline__ void operator()(const f32x4 (&acc)[2][2][4][2], const Unit& u, int wr, int wc, int fr, int fq) const {
        const int row0 = u.pm * BM + wr * 64 + fr, col0 = u.pn * BM + wc * 32 + 4 * fq;
        f32x4 gv[2][2], bv[2][2];
        if constexpr (LN) {
#pragma unroll
            for (int bj = 0; bj < 2; ++bj)
#pragma unroll
                for (int n = 0; n < 2; ++n) { gv[bj][n] = *(const f32x4*)(g + col0 + bj * HALF + n * 16) * alpha; bv[bj][n] = *(const f32x4*)(b + col0 + bj * HALF + n * 16) * alpha; }
        }
#pragma unroll
        for (int ai = 0; ai < 2; ++ai)
#pragma unroll
            for (int m = 0; m < 4; ++m) { const int row = row0 + ai * HALF + m * 16; const size_t off = (size_t)row * ldc + col0;
                f32x4 bs[2][2];
#pragma unroll
                for (int bj = 0; bj < 2; ++bj)
#pragma unroll
                    for (int n = 0; n < 2; ++n) bs[bj][n] = *(const f32x4*)(base + off + bj * HALF + n * 16);
                if constexpr (LN) {
                    const float mean = stats[2 * row], rstd = stats[2 * row + 1];
#pragma unroll
                    for (int bj = 0; bj < 2; ++bj)
#pragma unroll
                        for (int n = 0; n < 2; ++n) *(f32x4*)(out + off + bj * HALF + n * 16) = (bs[bj][n] - mean) * rstd * gv[bj][n] + bv[bj][n] + acc[ai][bj][m][n];
                } else {
#pragma unroll
                    for (int bj = 0; bj < 2; ++bj)
#pragma unroll
                        for (int n = 0; n < 2; ++n) *(f32x4*)(out + off + bj * HALF + n * 16) = bs[bj][n] * alpha + acc[ai][bj][m][n];
                }
                asm volatile("" ::: "memory"); }
    }
};

template <class Epi, class Sched, bool STAMP = false>
__device__ __forceinline__ void gemm_phase(PG8_LAS unsigned char* lds, const Gemm g, const Sched& S, const Epi& E, unsigned long long* stamps) {
    int tid = threadIdx.x; asm volatile("" : "+v"(tid));
    const int wid = __builtin_amdgcn_readfirstlane(tid >> 6), lane = tid & 63, wr = wid >> 2, wc = wid & 3, fr = lane & 15, fq = lane >> 4;
    const int K = g.K, nt = K / BK;
    int ts_lo = 0, ts_hi = 0, nts = 0; const unsigned long long rt_entry = STAMP ? (unsigned long long)wall_clock64() : 0ull;
#define PG8_STAMP() do { if (STAMP && wid == 0 && nts < 64) { const unsigned long long _c = (unsigned long long)clock64(); \
        ts_lo = (lane == nts) ? (int)(unsigned)_c : ts_lo; ts_hi = (lane == nts) ? (int)(unsigned)(_c >> 32) : ts_hi; ++nts; } } while (0)
    PG8_STAMP();
    unsigned voffA[2], voffB[2];
#pragma unroll
    for (int i = 0; i < 2; ++i) { int R, C; stage_rc(tid * 16 + i * 8192, R, C); const int Rb = Epi::PERM ? ((R & ~31) + perm32(R & 31)) : R;
        voffA[i] = (unsigned)(R * K + C) * 2u; voffB[i] = (unsigned)(Rb * K + C) * 2u; }
    const size_t kstep = (size_t)(BK * 2);
    const size_t hstep = (size_t)HALF * K * 2;
    const size_t tstep = 2 * hstep;
    const unsigned ldsw = (unsigned)wid * 1024u;
    const int aoff = lds_byte(wr * 64 + fr, fq * 8), boff = lds_byte(wc * 32 + fr, fq * 8);
#define PG8_SA(b, h) (((b) * 2 + (h)) * HTB)
#define PG8_SB(b, h) ((4 + (b) * 2 + (h)) * HTB)
#define PG8_STAGE(bufoff, gbase, voff) do { _Pragma("unroll") for (int _i = 0; _i < 2; ++_i) \
        __builtin_amdgcn_global_load_lds((const unsigned*)((const char*)(gbase) + (voff)[_i]), (PG8_LAS unsigned*)(lds + (bufoff) + ldsw + _i * 8192), 16, 0, 0); } while (0)
#define PG8_LDA(dst, b, h) do { _Pragma("unroll") for (int m = 0; m < 4; ++m) _Pragma("unroll") for (int k = 0; k < 2; ++k) dst[m][k] = *(const PG8_LAS bf16x8*)(lds + PG8_SA(b, h) + aoff + m * 2048 + k * 1024); } while (0)
#define PG8_LDB(dst, b, h) do { _Pragma("unroll") for (int n = 0; n < 2; ++n) _Pragma("unroll") for (int k = 0; k < 2; ++k) dst[n][k] = *(const PG8_LAS bf16x8*)(lds + PG8_SB(b, h) + boff + n * 2048 + k * 1024); } while (0)
#define PG8_MMA(ai, bj, At, Bt) do { __builtin_amdgcn_s_setprio(1); _Pragma("unroll") for (int m = 0; m < 4; ++m) _Pragma("unroll") for (int n = 0; n < 2; ++n) _Pragma("unroll") for (int k = 0; k < 2; ++k) \
        acc[ai][bj][m][n] = __builtin_amdgcn_mfma_f32_16x16x32_bf16(Bt[n][k], At[m][k], acc[ai][bj][m][n], 0, 0, 0); __builtin_amdgcn_s_setprio(0); } while (0)
#define PG8_WAIT_V(n) asm volatile("s_waitcnt vmcnt(" #n ")" ::: "memory")
#define PG8_WAIT_L(n) asm volatile("s_waitcnt lgkmcnt(" #n ")" ::: "memory")
#define PG8_BAR __builtin_amdgcn_s_barrier()
#define PG8_SCHED __builtin_amdgcn_sched_barrier(0)
    Unit cur, nxt; int ui = 0;
    if (!S.next(0, cur)) return;
    f32x4 acc[2][2][4][2];
#pragma unroll
    for (int a = 0; a < 2; ++a)
#pragma unroll
        for (int b = 0; b < 2; ++b)
#pragma unroll
            for (int m = 0; m < 4; ++m)
#pragma unroll
                for (int n = 0; n < 2; ++n) acc[a][b][m][n] = (f32x4){0.f, 0.f, 0.f, 0.f};
    bf16x8 At[4][2], B0[2][2], B1[2][2];
    const char* cA = (const char*)g.A + (size_t)cur.pm * tstep; const char* cB = (const char*)g.Bt + (size_t)cur.pn * tstep;
    S.a_ready(cur);
    PG8_STAGE(PG8_SB(0, 0), cB, voffB); PG8_STAGE(PG8_SA(0, 0), cA, voffA); PG8_STAGE(PG8_SB(0, 1), cB + hstep, voffB); PG8_STAGE(PG8_SA(0, 1), cA + hstep, voffA);
    if (wr == 1) PG8_BAR;
    PG8_WAIT_V(4); PG8_BAR;
    PG8_STAGE(PG8_SB(1, 0), cB + kstep, voffB); PG8_STAGE(PG8_SA(1, 0), cA + kstep, voffA); PG8_STAGE(PG8_SB(1, 1), cB + hstep + kstep, voffB);
    PG8_WAIT_V(6); PG8_BAR;
    PG8_STAMP();
    for (;;) {
        const bool has_next = S.next(ui + 1, nxt);
        const char* nA = has_next ? (const char*)g.A + (size_t)nxt.pm * tstep : cA; const char* nB = has_next ? (const char*)g.Bt + (size_t)nxt.pn * tstep : cB;
        for (int t = 0; t < nt; t += 2) {
            const bool last = (t == nt - 2);
            const char* a1 = cA + (size_t)(t + 1) * kstep;
            const char* a2 = last ? nA : cA + (size_t)(t + 2) * kstep; const char* b2 = last ? nB : cB + (size_t)(t + 2) * kstep;
            const char* a3 = a2 + kstep; const char* b3 = b2 + kstep;
            if (last && has_next) S.a_ready(nxt);
            PG8_LDB(B0, 0, 0); PG8_SCHED; PG8_LDA(At, 0, 0); PG8_STAGE(PG8_SA(1, 1), a1 + hstep, voffA);
            PG8_WAIT_L(8); PG8_BAR; PG8_WAIT_L(0); PG8_MMA(0, 0, At, B0); PG8_BAR; PG8_SCHED;
            PG8_LDB(B1, 0, 1); PG8_STAGE(PG8_SB(0, 0), b2, voffB);
            PG8_BAR; PG8_WAIT_L(0); PG8_MMA(0, 1, At, B1); PG8_BAR;
            PG8_LDA(At, 0, 1); PG8_STAGE(PG8_SA(0, 0), a2, voffA);
            PG8_BAR; PG8_WAIT_L(0); PG8_MMA(1, 0, At, B0); PG8_BAR; PG8_SCHED;
            PG8_STAGE(PG8_SB(0, 1), b2 + hstep, voffB);
            PG8_WAIT_V(6); PG8_BAR; PG8_MMA(1, 1, At, B1); PG8_BAR;
            PG8_LDB(B0, 1, 0); PG8_SCHED; PG8_LDA(At, 1, 0); PG8_STAGE(PG8_SA(0, 1), a2 + hstep, voffA);
            PG8_WAIT_L(8); PG8_BAR; PG8_WAIT_L(0); PG8_MMA(0, 0, At, B0); PG8_BAR; PG8_SCHED;
            PG8_LDB(B1, 1, 1); PG8_STAGE(PG8_SB(1, 0), b3, voffB);
            PG8_BAR; PG8_WAIT_L(0); PG8_MMA(0, 1, At, B1); PG8_BAR;
            PG8_LDA(At, 1, 1); PG8_STAGE(PG8_SA(1, 0), a3, voffA);
            PG8_BAR; PG8_WAIT_L(0); PG8_MMA(1, 0, At, B0); PG8_BAR; PG8_SCHED;
            PG8_STAGE(PG8_SB(1, 1), b3 + hstep, voffB);
            PG8_WAIT_V(6); PG8_BAR; PG8_MMA(1, 1, At, B1); PG8_BAR;
        }
        PG8_STAMP();
        if constexpr (!Epi::AFTER_DRAIN) { E(acc, cur, wr, wc, fr, fq); S.done(cur); }
        PG8_STAMP();
        if (!has_next) break;
#pragma unroll
        for (int a = 0; a < 2; ++a)
#pragma unroll
            for (int b = 0; b < 2; ++b)
#pragma unroll
                for (int m = 0; m < 4; ++m)
#pragma unroll
                    for (int n = 0; n < 2; ++n) acc[a][b][m][n] = (f32x4){0.f, 0.f, 0.f, 0.f};
        cur = nxt; cA = nA; cB = nB; ++ui;
    }
    PG8_WAIT_V(0);
    if (wr == 0) PG8_BAR;
    PG8_BAR;
    if constexpr (Epi::AFTER_DRAIN) { E.fused(acc, cur, wr, wc, fr, fq, lds, wid, lane); S.done(cur); }
    PG8_STAMP();
    if (STAMP && wid == 0) { stamps[lane] = lane < nts ? (((unsigned long long)(unsigned)ts_hi << 32) | (unsigned)ts_lo) : 0ull;
        if (lane == 62) stamps[62] = rt_entry; if (lane == 63) stamps[63] = (unsigned long long)wall_clock64(); }
#undef PG8_STAMP
#undef PG8_SA
#undef PG8_SB
#undef PG8_STAGE
#undef PG8_LDA
#undef PG8_LDB
#undef PG8_MMA
#undef PG8_WAIT_V
#undef PG8_WAIT_L
#undef PG8_BAR
#undef PG8_SCHED
}
}

enum { M_ROW = 0, M_TR = 1, M_UQ = 2, M_UKVK = 3, M_UKVV = 4, M_G3 = 5 };

struct Epi {
  u16* out; int out_ld;
  u16* vt; int seq; int nseg0; int hrows;
  const float* c32; const float* s32;
  const float* xprev; float* xout;
};

template <int MODE>
DI void gemm_tile(const u16* __restrict__ A, int lda, const u16* __restrict__ Bt, int ldb, int K,
                          int m0, int n0, const Epi& e, char* smem, const float* rs, const int tid_in) {
  int tid = tid_in; asm volatile("" : "+v"(tid));
  constexpr bool SWAP = (MODE == M_ROW || MODE == M_UQ || MODE == M_UKVK || MODE == M_G3);
  const int lane = tid & 63, wave = tid >> 6, r = lane & 31, h = lane >> 5;
  const int wm = wave >> 1, wn = wave & 1;
  f32x16 acc[4][2];
#pragma unroll
  for (int i = 0; i < 4; ++i)
#pragma unroll
    for (int j = 0; j < 2; ++j)
#pragma unroll
      for (int q = 0; q < 16; ++q) acc[i][j][q] = 0.f;

  const int lrow = tid >> 2, lch = (tid & 3) * 8;
  const u16* Ag = A + (size_t)(m0 + lrow) * lda + lch;
  const u16* Bg = Bt + (size_t)(n0 + lrow) * ldb + lch;
  u16* Aw = (u16*)smem + lrow * GROW + lch;
  const u16* Ar = (const u16*)smem + (wm * 128 + r) * GROW + 8 * h;
  const u16* Br = (const u16*)smem + (256 + wn * 64 + r) * GROW + 8 * h;
  constexpr int STG = G_STAGE / 2;
  u32x4 r0[6], r1[6];
  const int KT = K >> 5;
#define G_LOAD(R, kt_) { const int k0_ = (kt_) * 32; \
    _Pragma("unroll") for (int i = 0; i < 4; ++i) R[i] = *(const u32x4*)(Ag + (size_t)(64 * i) * lda + k0_); \
    _Pragma("unroll") for (int i = 0; i < 2; ++i) R[4 + i] = *(const u32x4*)(Bg + (size_t)(64 * i) * ldb + k0_); }
#define G_WRITE(R, st_) { \
    _Pragma("unroll") for (int i = 0; i < 4; ++i) *(u32x4*)(Aw + (st_) * STG + (64 * i) * GROW) = R[i]; \
    _Pragma("unroll") for (int i = 0; i < 2; ++i) *(u32x4*)(Aw + (st_) * STG + (256 + 64 * i) * GROW) = R[4 + i]; }
#define G_COMPUTE(st_) { \
    _Pragma("unroll") for (int ks = 0; ks < 2; ++ks) { \
      bf16x8 af[4], bfr[2]; \
      _Pragma("unroll") for (int mb = 0; mb < 4; ++mb) af[mb] = *(const bf16x8*)(Ar + (st_) * STG + mb * 32 * GROW + ks * 16); \
      _Pragma("unroll") for (int nb = 0; nb < 2; ++nb) bfr[nb] = *(const bf16x8*)(Br + (st_) * STG + nb * 32 * GROW + ks * 16); \
      _Pragma("unroll") for (int mb = 0; mb < 4; ++mb) \
        _Pragma("unroll") for (int nb = 0; nb < 2; ++nb) { \
          if (SWAP) acc[mb][nb] = MFMA(bfr[nb], af[mb], acc[mb][nb]); \
          else acc[mb][nb] = MFMA(af[mb], bfr[nb], acc[mb][nb]); } } }
  G_LOAD(r0, 0);
  G_LOAD(r1, 1);
  G_WRITE(r0, 0);
  __syncthreads();
  for (int kt = 0; kt < KT; kt += 2) {
    { const int kn = (kt + 2 < KT) ? kt + 2 : KT - 1; G_LOAD(r0, kn); }
    __builtin_amdgcn_sched_barrier(0);
    G_COMPUTE(0);
    __builtin_amdgcn_sched_barrier(0);
    G_WRITE(r1, 1);
    __syncthreads();
    { const int kn = (kt + 3 < KT) ? kt + 3 : KT - 1; G_LOAD(r1, kn); }
    __builtin_amdgcn_sched_barrier(0);
    G_COMPUTE(1);
    __builtin_amdgcn_sched_barrier(0);
    G_WRITE(r0, 0);
    __syncthreads();
  }
#undef G_LOAD
#undef G_WRITE
#undef G_COMPUTE

  if (MODE == M_G3) {
    const float alpha = 1.681792830507429f;
#pragma unroll
    for (int mb = 0; mb < 4; ++mb) {
      const int m = m0 + wm * 128 + mb * 32 + r;
      const float* xp = e.xprev + (size_t)m * DM + n0 + wn * 64 + 4 * h;
      float* op = e.xout + (size_t)m * DM + n0 + wn * 64 + 4 * h;
      f32x4 xv[2][4];
#pragma unroll
      for (int nb = 0; nb < 2; ++nb)
#pragma unroll
        for (int g = 0; g < 4; ++g) xv[nb][g] = *(const f32x4*)(xp + nb * 32 + 8 * g);
#pragma unroll
      for (int nb = 0; nb < 2; ++nb)
#pragma unroll
        for (int g = 0; g < 4; ++g) {
          f32x4 o;
          o.x = alpha * xv[nb][g].x + acc[mb][nb][4 * g];
          o.y = alpha * xv[nb][g].y + acc[mb][nb][4 * g + 1];
          o.z = alpha * xv[nb][g].z + acc[mb][nb][4 * g + 2];
          o.w = alpha * xv[nb][g].w + acc[mb][nb][4 * g + 3];
          *(f32x4*)(op + nb * 32 + 8 * g) = o;
        }
    }
  } else if (SWAP) {
#pragma unroll
    for (int mb = 0; mb < 4; ++mb) {
      const int ml = wm * 128 + mb * 32 + r;
      const int m = m0 + ml;
      f32x4 rcs[2], rsn[2];
      if (MODE == M_UQ) {
        if (n0 >= 256) {
#pragma unroll
          for (int g = 0; g < 2; ++g) {
            rcs[g] = *(const f32x4*)(e.c32 + (size_t)m * 16 + 8 * g + 4 * h);
            rsn[g] = *(const f32x4*)(e.s32 + (size_t)m * 16 + 8 * g + 4 * h);
          }
        }
      }
      float rsv = 1.0f;
      if (MODE == M_UQ || MODE == M_UKVK) rsv = rs[ml];
#pragma unroll
      for (int nb = 0; nb < 2; ++nb) {
        const int nbase = n0 + wn * 64 + nb * 32;
        if (MODE == M_ROW) {
#pragma unroll
          for (int g = 0; g < 4; ++g) {
            const int n = nbase + 8 * g + 4 * h;
            u32x2 v = mk2(pack2(acc[mb][nb][4 * g], acc[mb][nb][4 * g + 1]), pack2(acc[mb][nb][4 * g + 2], acc[mb][nb][4 * g + 3]));
            *(u32x2*)(e.out + (size_t)m * e.out_ld + n) = v;
          }
        } else if (MODE == M_UKVK) {
#pragma unroll
          for (int g = 0; g < 4; ++g) {
            const int n = nbase + 8 * g + 4 * h;
            u32x2 v = mk2(pack2(acc[mb][nb][4 * g] * rsv, acc[mb][nb][4 * g + 1] * rsv), pack2(acc[mb][nb][4 * g + 2] * rsv, acc[mb][nb][4 * g + 3] * rsv));
            *(u32x2*)(e.out + (size_t)m * 384 + (n >> 6) * 96 + (n & 63)) = v;
          }
        } else if (MODE == M_UQ) {
          if (n0 < 256) {
#pragma unroll
            for (int g = 0; g < 4; ++g) {
              const int n = nbase + 8 * g + 4 * h;
              u32x2 v = mk2(pack2(acc[mb][nb][4 * g] * rsv, acc[mb][nb][4 * g + 1] * rsv), pack2(acc[mb][nb][4 * g + 2] * rsv, acc[mb][nb][4 * g + 3] * rsv));
              *(u32x2*)(e.out + (size_t)m * 384 + (n >> 6) * 96 + (n & 63)) = v;
            }
          } else {
            const int head = wn * 2 + nb;
#pragma unroll
            for (int g = 0; g < 2; ++g) {
              const int d = 8 * g + 4 * h;
              const f32x4 cs = rcs[g];
              const f32x4 sn = rsn[g];
              const float c_[4] = {cs.x, cs.y, cs.z, cs.w}, s_[4] = {sn.x, sn.y, sn.z, sn.w};
              float o1[4], o2[4];
#pragma unroll
              for (int j = 0; j < 4; ++j) {
                const float x1 = acc[mb][nb][4 * g + j] * rsv, x2 = acc[mb][nb][4 * (g + 2) + j] * rsv;
                o1[j] = x1 * c_[j] - x2 * s_[j];
                o2[j] = x2 * c_[j] + x1 * s_[j];
              }
              u16* dst = e.out + (size_t)m * 384 + head * 96 + 64 + d;
              *(u32x2*)dst = mk2(pack2(o1[0], o1[1]), pack2(o1[2], o1[3]));
              *(u32x2*)(dst + 16) = mk2(pack2(o2[0], o2[1]), pack2(o2[2], o2[3]));
            }
          }
        } else if (MODE == M_G3) {
        }
      }
    }
  } else {
    const int b = m0 / e.seq, s0 = m0 % e.seq;
#pragma unroll
    for (int nb = 0; nb < 2; ++nb) {
      const int n = n0 + wn * 64 + nb * 32 + r;
      u16* rowp = e.vt + ((size_t)b * e.hrows + (n - e.nseg0)) * e.seq + s0;
#pragma unroll
      for (int mb = 0; mb < 4; ++mb) {
#pragma unroll
        for (int g = 0; g < 4; ++g) {
          const int ml = wm * 128 + mb * 32 + 8 * g + 4 * h;
          float v0 = acc[mb][nb][4 * g], v1 = acc[mb][nb][4 * g + 1], v2 = acc[mb][nb][4 * g + 2], v3 = acc[mb][nb][4 * g + 3];
          if (MODE == M_UKVV) {
            const f32x4 rv = *(const f32x4*)(rs + ml);
            v0 *= rv.x; v1 *= rv.y; v2 *= rv.z; v3 *= rv.w;
          }
          *(u32x2*)(rowp + ml) = mk2(pack2(v0, v1), pack2(v2, v3));
        }
      }
    }
  }
}

template <int MODE, int KT>
DI void mla_tile8(const u16* __restrict__ Bt, int ldb, int m0, int n0, const Epi& e, char* smem, const float* rs, const int tid_in) {
  int tid = tid_in; asm volatile("" : "+v"(tid));
  constexpr bool SWAP = (MODE == M_ROW || MODE == M_UQ || MODE == M_UKVK || MODE == M_G3);
  const int lane = tid & 63, wave = tid >> 6, r = lane & 31, h = lane >> 5;
  const int wm = wave >> 1, wn = wave & 1;
  f32x16 acc[2][2];
#pragma unroll
  for (int i = 0; i < 2; ++i)
#pragma unroll
    for (int j = 0; j < 2; ++j)
#pragma unroll
      for (int q = 0; q < 16; ++q) acc[i][j][q] = 0.f;
  constexpr int A_STEP = 256 * GROW;
  constexpr int B_STG = 128 * GROW;
  const int lrow = tid >> 2, lch = (tid & 3) * 8;
  const u16* Bg = Bt + (size_t)(n0 + lrow) * ldb + lch;
  u16* Bw = (u16*)smem + KT * A_STEP + lrow * GROW + lch;
  const u16* Ar = (const u16*)smem + (wm * 64 + r) * GROW + 8 * h;
  const u16* Br = (const u16*)smem + KT * A_STEP + (wn * 64 + r) * GROW + 8 * h;
  u32x4 rb[KT];
#pragma unroll
  for (int kt = 0; kt < KT; ++kt) rb[kt] = *(const u32x4*)(Bg + kt * 32);
  *(u32x4*)(Bw) = rb[0];
  __syncthreads();
#pragma unroll
  for (int kt = 0; kt < KT; ++kt) {
    if (kt + 1 < KT) *(u32x4*)(Bw + ((kt + 1) & 1) * B_STG) = rb[kt + 1];
#pragma unroll
    for (int ks = 0; ks < 2; ++ks) {
      bf16x8 af[2], bfr[2];
#pragma unroll
      for (int mb = 0; mb < 2; ++mb) af[mb] = *(const bf16x8*)(Ar + kt * A_STEP + mb * 32 * GROW + ks * 16);
#pragma unroll
      for (int nb = 0; nb < 2; ++nb) bfr[nb] = *(const bf16x8*)(Br + (kt & 1) * B_STG + nb * 32 * GROW + ks * 16);
#pragma unroll
      for (int mb = 0; mb < 2; ++mb)
#pragma unroll
        for (int nb = 0; nb < 2; ++nb) {
          if (SWAP) acc[mb][nb] = MFMA(bfr[nb], af[mb], acc[mb][nb]);
          else acc[mb][nb] = MFMA(af[mb], bfr[nb], acc[mb][nb]);
        }
    }
    __syncthreads();
  }

  if (MODE == M_G3) {
    const float alpha = 1.681792830507429f;
#pragma unroll
    for (int mb = 0; mb < 2; ++mb) {
      const int m = m0 + wm * 64 + mb * 32 + r;
      const float* xp = e.xprev + (size_t)m * DM + n0 + wn * 64 + 4 * h;
      float* op = e.xout + (size_t)m * DM + n0 + wn * 64 + 4 * h;
      f32x4 xv[2][4];
#pragma unroll
      for (int nb = 0; nb < 2; ++nb)
#pragma unroll
        for (int g = 0; g < 4; ++g) xv[nb][g] = *(const f32x4*)(xp + nb * 32 + 8 * g);
#pragma unroll
      for (int nb = 0; nb < 2; ++nb)
#pragma unroll
        for (int g = 0; g < 4; ++g) {
          f32x4 o;
          o.x = alpha * xv[nb][g].x + acc[mb][nb][4 * g];
          o.y = alpha * xv[nb][g].y + acc[mb][nb][4 * g + 1];
          o.z = alpha * xv[nb][g].z + acc[mb][nb][4 * g + 2];
          o.w = alpha * xv[nb][g].w + acc[mb][nb][4 * g + 3];
          *(f32x4*)(op + nb * 32 + 8 * g) = o;
        }
    }
  } else if (SWAP) {
#pragma unroll
    for (int mb = 0; mb < 2; ++mb) {
      const int ml = wm * 64 + mb * 32 + r;
      const int m = m0 + ml;
      f32x4 rcs[2], rsn[2];
      if (MODE == M_UQ) {
        if (n0 >= 256) {
#pragma unroll
          for (int g = 0; g < 2; ++g) {
            rcs[g] = *(const f32x4*)(e.c32 + (size_t)m * 16 + 8 * g + 4 * h);
            rsn[g] = *(const f32x4*)(e.s32 + (size_t)m * 16 + 8 * g + 4 * h);
          }
        }
      }
      float rsv = 1.0f;
      if (MODE == M_UQ || MODE == M_UKVK) rsv = rs[ml];
#pragma unroll
      for (int nb = 0; nb < 2; ++nb) {
        const int nbase = n0 + wn * 64 + nb * 32;
        if (MODE == M_ROW) {
#pragma unroll
          for (int g = 0; g < 4; ++g) {
            const int n = nbase + 8 * g + 4 * h;
            u32x2 v = mk2(pack2(acc[mb][nb][4 * g], acc[mb][nb][4 * g + 1]), pack2(acc[mb][nb][4 * g + 2], acc[mb][nb][4 * g + 3]));
            *(u32x2*)(e.out + (size_t)m * e.out_ld + n) = v;
          }
        } else if (MODE == M_UKVK) {
#pragma unroll
          for (int g = 0; g < 4; ++g) {
            const int n = nbase + 8 * g + 4 * h;
            u32x2 v = mk2(pack2(acc[mb][nb][4 * g] * rsv, acc[mb][nb][4 * g + 1] * rsv), pack2(acc[mb][nb][4 * g + 2] * rsv, acc[mb][nb][4 * g + 3] * rsv));
            *(u32x2*)(e.out + (size_t)m * 384 + (n >> 6) * 96 + (n & 63)) = v;
          }
        } else if (MODE == M_UQ) {
          if (n0 < 256) {
#pragma unroll
            for (int g = 0; g < 4; ++g) {
              const int n = nbase + 8 * g + 4 * h;
              u32x2 v = mk2(pack2(acc[mb][nb][4 * g] * rsv, acc[mb][nb][4 * g + 1] * rsv), pack2(acc[mb][nb][4 * g + 2] * rsv, acc[mb][nb][4 * g + 3] * rsv));
              *(u32x2*)(e.out + (size_t)m * 384 + (n >> 6) * 96 + (n & 63)) = v;
            }
          } else {
            const int head = wn * 2 + nb;
#pragma unroll
            for (int g = 0; g < 2; ++g) {
              const int d = 8 * g + 4 * h;
              const f32x4 cs = rcs[g];
              const f32x4 sn = rsn[g];
              const float c_[4] = {cs.x, cs.y, cs.z, cs.w}, s_[4] = {sn.x, sn.y, sn.z, sn.w};
              float o1[4], o2[4];
#pragma unroll
              for (int j = 0; j < 4; ++j) {
                const float x1 = acc[mb][nb][4 * g + j] * rsv, x2 = acc[mb][nb][4 * (g + 2) + j] * rsv;
                o1[j] = x1 * c_[j] - x2 * s_[j];
                o2[j] = x2 * c_[j] + x1 * s_[j];
              }
              u16* dst = e.out + (size_t)m * 384 + head * 96 + 64 + d;
              *(u32x2*)dst = mk2(pack2(o1[0], o1[1]), pack2(o1[2], o1[3]));
              *(u32x2*)(dst + 16) = mk2(pack2(o2[0], o2[1]), pack2(o2[2], o2[3]));
            }
          }
        } else if (MODE == M_G3) {
        }
      }
    }
  } else {
    const int b = m0 / e.seq, s0 = m0 % e.seq;
#pragma unroll
    for (int nb = 0; nb < 2; ++nb) {
      const int n = n0 + wn * 64 + nb * 32 + r;
      u16* rowp = e.vt + ((size_t)b * e.hrows + (n - e.nseg0)) * e.seq + s0;
#pragma unroll
      for (int mb = 0; mb < 2; ++mb) {
#pragma unroll
        for (int g = 0; g < 4; ++g) {
          const int ml = wm * 64 + mb * 32 + 8 * g + 4 * h;
          float v0 = acc[mb][nb][4 * g], v1 = acc[mb][nb][4 * g + 1], v2 = acc[mb][nb][4 * g + 2], v3 = acc[mb][nb][4 * g + 3];
          if (MODE == M_UKVV) {
            const f32x4 rv = *(const f32x4*)(rs + ml);
            v0 *= rv.x; v1 *= rv.y; v2 *= rv.z; v3 *= rv.w;
          }
          *(u32x2*)(rowp + ml) = mk2(pack2(v0, v1), pack2(v2, v3));
        }
      }
    }
  }
}

template <int KT>
DI void mla_load_a(const u16* proj, int m0, int col0, char* smem, const int tid_in) {
  int tid = tid_in; asm volatile("" : "+v"(tid));
  const int lrow = tid >> 2, lch = (tid & 3) * 8;
  const u16* Ag = proj + (size_t)(m0 + lrow) * NP + col0 + lch;
  u32x4 ra[KT][2];
#pragma unroll
  for (int kt = 0; kt < KT; ++kt)
#pragma unroll
    for (int i = 0; i < 2; ++i) ra[kt][i] = *(const u32x4*)(Ag + (size_t)(128 * i) * NP + kt * 32);
  u16* Aw = (u16*)smem + lrow * GROW + lch;
#pragma unroll
  for (int kt = 0; kt < KT; ++kt)
#pragma unroll
    for (int i = 0; i < 2; ++i) *(u32x4*)(Aw + kt * (256 * GROW) + (128 * i) * GROW) = ra[kt][i];
}

template <int KDIM>
DI void compute_rs(const u16* proj, int m0, int col0, float* rs, const int tid_in) {
  int tid = tid_in; asm volatile("" : "+v"(tid));
  const u16* rowp = proj + (size_t)(m0 + tid) * NP + col0;
  u32x4 v[KDIM / 8];
#pragma unroll
  for (int c = 0; c < KDIM / 8; ++c) v[c] = *(const u32x4*)(rowp + c * 8);
  float ss = 0.f;
#pragma unroll
  for (int c = 0; c < KDIM / 8; ++c) {
    const unsigned w[4] = {v[c].x, v[c].y, v[c].z, v[c].w};
#pragma unroll
    for (int i = 0; i < 4; ++i) { const float a = lo_f(w[i]), b = hi_f(w[i]); ss += a * a + b * b; }
  }
  rs[tid] = rsqrtf(ss / (float)KDIM + 1e-6f);
}

struct AttnBlk {
  const u16* k; int k_ld;
  const u16* vt; int vt_ld;
  int kt_begin, kt_end;
  int c;
};
struct AttnWave {
  const u16* q; int q_ld;
  const u16* gate;
  u16* out;
  int hoff;
  int my_kt_end;
  float m_init; float l_init;
  const float* bias;
  int qi0;
};

#ifndef ATT_HINTS
#define ATT_HINTS 1
#endif
template <int DQK, int NH, int MODE, int PROBE = 0>
DI void attn_item(const AttnBlk& ab, const AttnWave& aw, char* smem, const int tid_in) {
  int tid = tid_in; asm volatile("" : "+v"(tid));
  constexpr int KCOLS = NH * DQK;
  constexpr int KROWB = (KCOLS + 8) * 2;
  constexpr int CPR = KCOLS / 8;
  constexpr int KTOT = 64 * CPR;
  constexpr int NKC = (KTOT + 511) / 512;
  constexpr int NVC = NH;
  constexpr int KIMG = 64 * KROWB;
  constexpr int STAGE = KIMG + NH * 64 * VROWB;
  constexpr int NKS = DQK / 16;
  constexpr bool DEEP = false;
  const int lane = tid & 63, r = lane & 31, h = lane >> 5;

  bf16x8 qf[NKS];
#pragma unroll
  for (int ks = 0; ks < NKS; ++ks) qf[ks] = *(const bf16x8*)(aw.q + (size_t)r * aw.q_ld + ks * 16 + 8 * h);

  f32x16 o0, o1;
#pragma unroll
  for (int i = 0; i < 16; ++i) { o0[i] = 0.f; o1[i] = 0.f; }
  float l = aw.l_init;
  f32x16 cinit;
#pragma unroll
  for (int i = 0; i < 16; ++i) cinit[i] = 0.f;
  constexpr bool CSHIFT = (NH != 4);
  float msub = 0.f;

  const int t0 = ab.kt_begin, te = ab.kt_end, nt = te - t0;
  const int my_n = aw.my_kt_end - t0;
  const gptr_t kb_ = uniform_ptr(ab.k); const gptr_t vb_ = uniform_ptr(ab.vt);
  const int kld_ = __builtin_amdgcn_readfirstlane(ab.k_ld), vld_ = __builtin_amdgcn_readfirstlane(ab.vt_ld);
  constexpr bool AFFINE = ((CPR & (CPR - 1)) == 0) && (KTOT % 512 == 0);
  unsigned koff[AFFINE ? 1 : NKC], voff[1];
  if constexpr (AFFINE) { koff[0] = (unsigned)((tid / CPR) * kld_ + (tid % CPR) * 8) * 2u; }
  else {
#pragma unroll
    for (int i = 0; i < NKC; ++i) { int id = tid + 512 * i; id = id < KTOT ? id : id - 512; const int row = id / CPR, cc = id % CPR; koff[i] = (unsigned)(row * kld_ + cc * 8) * 2u; }
  }
  voff[0] = (unsigned)((tid >> 3) * vld_ + (tid & 7) * 8) * 2u;
  const unsigned kstr_ = (unsigned)((512 / CPR) * kld_) * 2u, vstr_ = (unsigned)(64 * vld_) * 2u;
  u32x4 rk0[NKC], rv0[NVC], rk1[NKC], rv1[NVC];
#define A_LOADK(RK, j_) { const int t_ = (t0 + (j_) < te) ? t0 + (j_) : te - 1; const gptr_t kp_ = kb_ + (size_t)t_ * 128 * (size_t)kld_; \
    _Pragma("unroll") for (int i = 0; i < NKC; ++i) RK[i] = *(const __attribute__((address_space(1))) u32x4*)(kp_ + (AFFINE ? (size_t)i * kstr_ + koff[0] : (size_t)koff[AFFINE ? 0 : i])); }
#define A_LOADV(RV, j_) { const int t_ = (t0 + (j_) < te) ? t0 + (j_) : te - 1; const gptr_t vp_ = vb_ + (size_t)t_ * 128; \
    _Pragma("unroll") for (int i = 0; i < NVC; ++i) RV[i] = *(const __attribute__((address_space(1))) u32x4*)(vp_ + ((size_t)i * vstr_ + voff[0])); }
#define A_WRITEK(RK, st_) { char* Kw_ = smem + (st_) * STAGE; \
    _Pragma("unroll") for (int i = 0; i < NKC; ++i) { int id = tid + 512 * i; id = id < KTOT ? id : id - 512; const int row = id / CPR, cc = id % CPR; \
      *(u32x4*)(Kw_ + row * KROWB + cc * 16) = RK[i]; } }
#define A_WRITEV(RV, st_) { char* Vw_ = smem + (st_) * STAGE + KIMG; \
    _Pragma("unroll") for (int i = 0; i < NVC; ++i) { const int id = tid + 512 * i, row = id >> 3, cc = id & 7; \
      char* d_ = Vw_ + row * VROWB + (cc >> 1) * 32 + (cc & 1) * 8; \
      *(u32x2*)d_ = mk2(RV[i].x, RV[i].y); *(u32x2*)(d_ + 16) = mk2(RV[i].z, RV[i].w); } }

  const char* kl0 = smem + r * KROWB + (aw.hoff * DQK + 8 * h) * 2;
  const char* vl0 = smem + KIMG + (aw.hoff * 64 + r) * VROWB + h * 16;
  f32x16 sa0, sa1, sb0, sb1;

  auto kload = [&](const int st, bf16x8 (&kf)[2 * NKS]) {
    const char* kl = kl0 + st * STAGE;
#pragma unroll
    for (int ks = 0; ks < NKS; ++ks) { kf[2 * ks] = *(const bf16x8*)(kl + ks * 32); kf[2 * ks + 1] = *(const bf16x8*)(kl + 32 * KROWB + ks * 32); }
  };
  auto qk = [&](const bf16x8 (&kf)[2 * NKS], f32x16& a0, f32x16& a1) {
    a0 = MFMA(kf[0], qf[0], cinit);
    a1 = MFMA(kf[1], qf[0], cinit);
#pragma unroll
    for (int ks = 1; ks < NKS; ++ks) { a0 = MFMA(kf[2 * ks], qf[ks], a0); a1 = MFMA(kf[2 * ks + 1], qf[ks], a1); }
  };
  auto step = [&](const int stk, const int stv, const int kt, f32x16& s0, f32x16& s1, f32x16& n0, f32x16& n1) {
    bf16x8 kf[2 * NKS];
    kload(stk, kf);
    __builtin_amdgcn_sched_barrier(0);
    if (MODE == 1) {
      const int dc = ab.c - kt;
      if (dc >= 3) {
        const float bv = aw.bias[256];
#pragma unroll
        for (int i = 0; i < 16; ++i) { s0[i] += bv; s1[i] += bv; }
      } else {
        const int base = 64 * dc + aw.qi0 + r + 128;
#pragma unroll
        for (int i = 0; i < 16; ++i) {
          const int ki = (i & 3) + 8 * (i >> 2) + 4 * h;
          int i0 = base - ki; i0 = i0 > 256 ? 256 : i0;
          int i1 = base - 32 - ki; i1 = i1 > 256 ? 256 : i1;
          s0[i] += aw.bias[i0];
          s1[i] += aw.bias[i1];
        }
      }
    }
    const char* vl = vl0 + stv * STAGE;
    u32x4 vr[4][2];
#define V_READ(b_) { _Pragma("unroll") for (int db = 0; db < 2; ++db) vr[b_][db] = *(const u32x4*)(vl + (b_) * 32 + db * 32 * VROWB); }
    V_READ(0);
    __builtin_amdgcn_sched_barrier(0);
    qk(kf, n0, n1);
    f32x2_t ps2 = {0.f, 0.f};
#pragma unroll
    for (int i = 0; i < 16; i += 2) {
      if constexpr (CSHIFT) {
        s0[i] = fast_exp2(s0[i]); s0[i + 1] = fast_exp2(s0[i + 1]);
        s1[i] = fast_exp2(s1[i]); s1[i + 1] = fast_exp2(s1[i + 1]);
      } else {
        s0[i] = fast_exp2(s0[i] - msub); s0[i + 1] = fast_exp2(s0[i + 1] - msub);
        s1[i] = fast_exp2(s1[i] - msub); s1[i + 1] = fast_exp2(s1[i + 1] - msub);
      }
      f32x2_t a = {s0[i], s0[i + 1]}, b = {s1[i], s1[i + 1]};
      ps2 += a; ps2 += b;
    }
    l += ps2.x + ps2.y;
#pragma unroll
    for (int kb = 0; kb < 2; ++kb) {
#pragma unroll
      for (int s2 = 0; s2 < 2; ++s2) {
        const int bq = kb * 2 + s2;
        if (bq == 0) { V_READ(1); } else if (bq == 1) { V_READ(2); } else if (bq == 2) { V_READ(3); }
        u32x4 pw;
        if (kb == 0) pw = mk4(pack2(s0[8 * s2], s0[8 * s2 + 1]), pack2(s0[8 * s2 + 2], s0[8 * s2 + 3]), pack2(s0[8 * s2 + 4], s0[8 * s2 + 5]), pack2(s0[8 * s2 + 6], s0[8 * s2 + 7]));
        else pw = mk4(pack2(s1[8 * s2], s1[8 * s2 + 1]), pack2(s1[8 * s2 + 2], s1[8 * s2 + 3]), pack2(s1[8 * s2 + 4], s1[8 * s2 + 5]), pack2(s1[8 * s2 + 6], s1[8 * s2 + 7]));
        const bf16x8 pf = __builtin_bit_cast(bf16x8, pw);
        {
          const bf16x8 vf = __builtin_bit_cast(bf16x8, vr[bq][0]);
          o0 = MFMA(vf, pf, o0);
        }
        {
          const bf16x8 vf = __builtin_bit_cast(bf16x8, vr[bq][1]);
          o1 = MFMA(vf, pf, o1);
        }
      }
    }
#undef V_READ
  };

  constexpr bool PAIR = (NH == 1 && DQK == 96);
  if constexpr (PAIR) {
    A_LOADK(rk0, 0); A_LOADV(rv0, 0); A_LOADK(rk1, 1); A_LOADV(rv1, 1);
    A_WRITEK(rk0, 0); A_WRITEV(rv0, 0); A_WRITEK(rk1, 1); A_WRITEV(rv1, 1);
    A_LOADK(rk0, 2);
    A_WRITEK(rk0, 2);
    A_LOADK(rk0, 3); A_LOADK(rk1, 4); A_LOADV(rv0, 2); A_LOADV(rv1, 3);
  } else if constexpr (DEEP) {
    A_LOADK(rk0, 0); A_LOADV(rv0, 0); A_LOADK(rk1, 1);
    A_WRITEK(rk0, 0); A_WRITEV(rv0, 0); A_WRITEK(rk1, 1);
    A_LOADK(rk0, 2); A_LOADV(rv1, 1); A_LOADK(rk1, 3); A_LOADV(rv0, 2);
  } else {
    A_LOADK(rk0, 0); A_LOADV(rv0, 0); A_LOADK(rk1, 1);
    A_WRITEK(rk0, 0); A_WRITEV(rv0, 0); A_WRITEK(rk1, 1);
    A_LOADK(rk0, 2); A_LOADV(rv0, 1);
  }
  __syncthreads();
  if (PROBE != 1) {
    bf16x8 kf0[2 * NKS]; kload(0, kf0); qk(kf0, sa0, sa1);
    float mx = sa0[0];
#pragma unroll
    for (int i = 1; i < 16; ++i) mx = fmaxf(mx, sa0[i]);
#pragma unroll
    for (int i = 0; i < 16; ++i) mx = fmaxf(mx, sa1[i]);
    mx = fmaxf(mx, __shfl_xor(mx, 32));
    const float m0 = (MODE == 2) ? fmaxf(mx, aw.m_init) : mx;
    if (MODE == 2) l = ((lane < 32) ? 1.0f : 0.0f) * fast_exp2(aw.m_init - m0);
    if constexpr (CSHIFT) {
#pragma unroll
      for (int i = 0; i < 16; ++i) cinit[i] = -m0;
      qk(kf0, sa0, sa1);
    } else { msub = m0; }
  }
  __syncthreads();
  if constexpr (PAIR) {
    for (int j = 0; j < nt; j += 4) {
      A_WRITEK(rk0, 3); A_WRITEK(rk1, 0); A_WRITEV(rv0, 2); A_WRITEV(rv1, 3);
      A_LOADK(rk0, j + 5); A_LOADK(rk1, j + 6); A_LOADV(rv0, j + 4); A_LOADV(rv1, j + 5);
      if (PROBE != 1 && j < my_n) step(1, 0, t0 + j, sa0, sa1, sb0, sb1);
      if (PROBE != 1 && j + 1 < my_n) step(2, 1, t0 + j + 1, sb0, sb1, sa0, sa1);
      __syncthreads();
      if (j + 2 >= nt) break;
      A_WRITEK(rk0, 1); A_WRITEK(rk1, 2); A_WRITEV(rv0, 0); A_WRITEV(rv1, 1);
      A_LOADK(rk0, j + 7); A_LOADK(rk1, j + 8); A_LOADV(rv0, j + 6); A_LOADV(rv1, j + 7);
      if (PROBE != 1 && j + 2 < my_n) step(3, 2, t0 + j + 2, sa0, sa1, sb0, sb1);
      if (PROBE != 1 && j + 3 < my_n) step(0, 3, t0 + j + 3, sb0, sb1, sa0, sa1);
      __syncthreads();
    }
  } else
  for (int j = 0; j < nt; j += 2) {
    if constexpr (DEEP) { A_WRITEK(rk0, 0); A_WRITEV(rv1, 1); A_LOADK(rk0, j + 4); A_LOADV(rv1, j + 3); }
    else { A_WRITEK(rk0, 0); A_WRITEV(rv0, 1); A_LOADK(rk0, j + 3); A_LOADV(rv0, j + 2); }
    if (PROBE != 1 && j < my_n) step(1, 0, t0 + j, sa0, sa1, sb0, sb1);
    __syncthreads();
    if (j + 1 >= nt) break;
    if constexpr (DEEP) { A_WRITEK(rk1, 1); A_WRITEV(rv0, 0); A_LOADK(rk1, j + 5); A_LOADV(rv0, j + 4); }
    else { A_WRITEK(rk0, 1); A_WRITEV(rv0, 0); A_LOADK(rk0, j + 4); A_LOADV(rv0, j + 3); }
    if (PROBE != 1 && j + 1 < my_n) step(0, 1, t0 + j + 1, sb0, sb1, sa0, sa1);
    __syncthreads();
  }
#undef A_LOADK
#undef A_LOADV
#undef A_WRITEK
#undef A_WRITEV
  const float lt = l + __shfl_xor(l, 32);
  const float inv = 1.0f / lt;
  u32x2 gv[2][4];
#pragma unroll
  for (int db = 0; db < 2; ++db)
#pragma unroll
    for (int g = 0; g < 4; ++g) gv[db][g] = *(const u32x2*)(aw.gate + (size_t)r * NP + db * 32 + 8 * g + 4 * h);
#pragma unroll
  for (int db = 0; db < 2; ++db) {
#pragma unroll
    for (int g = 0; g < 4; ++g) {
      const int d0 = db * 32 + 8 * g + 4 * h;
      float v[4];
#pragma unroll
      for (int j = 0; j < 4; ++j) v[j] = (db == 0 ? o0[4 * g + j] : o1[4 * g + j]) * inv;
      v[0] *= silu_f(lo_f(gv[db][g].x)); v[1] *= silu_f(hi_f(gv[db][g].x));
      v[2] *= silu_f(lo_f(gv[db][g].y)); v[3] *= silu_f(hi_f(gv[db][g].y));
      if (PROBE == 0) *(u32x2*)(aw.out + (size_t)r * DM + d0) = mk2(pack2(v[0], v[1]), pack2(v[2], v[3]));
      else if (v[0] == 123.456f) *(u32x2*)(aw.out + (size_t)r * DM + d0) = mk2(pack2(v[0], v[1]), pack2(v[2], v[3]));
    }
  }
}

struct WorkQ { unsigned* ctr; int x; int dx; int per; int* slot; };
DI WorkQ wq_init(const Params& p, int l, int phase, int x, int per, char* smem) {
  WorkQ w; w.ctr = (unsigned*)(p.ws + OFF_WQ) + ((size_t)(l * 4 + phase) * 8) * 16; w.x = x & 0x107; w.dx = 0; w.per = per;
  w.slot = (int*)(smem + SM_ITEM);
  return w;
}
DI int wq_next(WorkQ& w, int& q) {
  for (;;) {
    if (w.dx >= 8) return -1;
    q = (w.x + w.dx) & 7;
    __syncthreads();
    if (threadIdx.x == 0) *w.slot = (int)__hip_atomic_fetch_add(&w.ctr[q * 16], 1u, __ATOMIC_RELAXED, __HIP_MEMORY_SCOPE_AGENT);
    __syncthreads();
    const int t = __builtin_amdgcn_readfirstlane(*w.slot);
    if (t < w.per) return t;
    w.dx += (w.x & 0x100) ? 8 : 1;
  }
}

DI void phase_gemm(const Params& p, int l, int which, int cperm, pg8::PG8_LAS_T lds) {
  char* ws = p.ws;
  pg8::Gemm g; pg8::EpiBf16 E;
  if (which == 0) { g.A = (const u16*)(ws + OFF_XB); g.Bt = (const u16*)(ws + OFF_WIN) + (size_t)l * NP * DM; g.M = T_TOK; g.N = NP; E.O = (u16*)(ws + OFF_PROJ); }
  else if (which == 1) { g.A = (const u16*)(ws + OFF_MEMB); g.Bt = (const u16*)(ws + OFF_WMKV); g.M = 4096; g.N = 2048; E.O = (u16*)(ws + OFF_KVMEM); }
  else { g.A = (const u16*)(ws + OFF_GATED); g.Bt = (const u16*)(ws + OFF_WOUT) + (size_t)l * DM * DM; g.M = T_TOK; g.N = DM; E.O = (u16*)(ws + OFF_PROJ); }
  g.K = DM; E.ldc = g.N; E.nt = (which == 0) ? 1 : 0;
  pg8::StaticOrder S; S.init(g.M, g.N, (int)gridDim.x, cperm);
  pg8::gemm_phase<pg8::EpiBf16, pg8::StaticOrder, false>(lds, g, S, E, nullptr);
}

template <int NHD, class SrcF, class DstF>
DI void vt_strip(SrcF src_of, int src_ld, DstF dst_of, int dst_ld, u16* T, int tid_in) {
  int tid = tid_in; asm volatile("" : "+v"(tid));
  const int rr = tid >> 3, ch = tid & 7;
  u32x4 v[NHD];
#pragma unroll
  for (int hd = 0; hd < NHD; ++hd) v[hd] = __builtin_nontemporal_load((const u32x4*)(src_of(hd) + (size_t)rr * src_ld + ch * 8));
#pragma unroll
  for (int hd = 0; hd < NHD; ++hd) {
    u16* Th = T + hd * (64 * 72);
    const unsigned w[4] = {v[hd].x, v[hd].y, v[hd].z, v[hd].w};
#pragma unroll
    for (int j = 0; j < 4; ++j) {
      Th[(ch * 8 + 2 * j) * 72 + ((rr + 8 * ch) & 63)] = (u16)(w[j] & 0xffffu);
      Th[(ch * 8 + 2 * j + 1) * 72 + ((rr + 8 * ch) & 63)] = (u16)(w[j] >> 16);
    }
  }
  __syncthreads();
#pragma unroll
  for (int hd = 0; hd < NHD; ++hd)
    *(u32x4*)(dst_of(hd) + (size_t)rr * dst_ld + ch * 8) = *(const u32x4*)(T + hd * (64 * 72) + rr * 72 + ((ch + (rr >> 3)) & 7) * 8);
  __syncthreads();
}

DI void phase_b1(const Params& p, int l, int xcd, char* smem) {
  char* ws = p.ws;
  u16* proj = (u16*)(ws + OFF_PROJ);
  const int tid = opaque_tid();
  {
    float* rs = (float*)(smem + SM_RS);
    WorkQ w = wq_init(p, l, 1, xcd, 64, smem);
    for (;;) {
      int q; const int u2 = wq_next(w, q);
      if (u2 < 0) break;
      const int grp = u2 >> 5, mt = 32 * q + (u2 & 31);
      const int m0 = mt * 256;
      Epi e{};
      if (grp == 0) {
        mla_load_a<6>(proj, m0, C_BCQ, smem, tid);
        if (tid < 256) compute_rs<192>(proj, m0, C_BCQ, rs, tid);
        __syncthreads();
        e.out = (u16*)(ws + OFF_QB); e.c32 = (const float*)(ws + OFF_COS32); e.s32 = (const float*)(ws + OFF_SIN32);
        for (int j = 0; j < 3; ++j)
          mla_tile8<M_UQ, 6>((const u16*)(ws + OFF_WUQ) + (size_t)l * 384 * 192, 192, m0, j * 128, e, smem, rs, tid);
      } else {
        mla_load_a<4>(proj, m0, C_BCKV, smem, tid);
        if (tid < 256) compute_rs<128>(proj, m0, C_BCKV, rs, tid);
        __syncthreads();
        const u16* wk = (const u16*)(ws + OFF_WUKV) + (size_t)l * 512 * 128;
        e.out = (u16*)(ws + OFF_KB);
        for (int nt = 0; nt < 2; ++nt)
          mla_tile8<M_UKVK, 4>(wk, 128, m0, nt * 128, e, smem, rs, tid);
        e.vt = (u16*)(ws + OFF_VTB); e.seq = SEQ; e.nseg0 = 256; e.hrows = 256;
        for (int nt = 2; nt < 4; ++nt)
          mla_tile8<M_UKVV, 4>(wk, 128, m0, nt * 128, e, smem, rs, tid);
      }
    }
  }
  __syncthreads();
  {
    u16* T = (u16*)smem;
    for (int tt = blockIdx.x; tt < 1024; tt += gridDim.x) {
      const int b = tt >> 6, s0 = (tt & 63) * 64;
      const u16* srow = proj + (size_t)tt * 64 * NP;
      u16* vta = (u16*)(ws + OFF_VTA) + ((size_t)(b * 4) * 64) * SEQ + s0;
      u16* vtc = (u16*)(ws + OFF_VTC) + ((size_t)(b * 2) * 64) * SEQ + s0;
      vt_strip<6>([&](int hd) { return srow + (hd < 4 ? C_AV + hd * 64 : C_CV + (hd - 4) * 64); }, NP,
                  [&](int hd) { return hd < 4 ? vta + (size_t)hd * 64 * SEQ : vtc + (size_t)(hd - 4) * 64 * SEQ; }, SEQ, T, tid);
    }
    if (l == 0) {
      for (int v = blockIdx.x; v < 256; v += gridDim.x) {
        const int ll = v >> 6, tt = v & 63;
        const int b = tt >> 2, s0 = (tt & 3) * 64;
        const u16* srow = (const u16*)(ws + OFF_KVMEM) + (size_t)tt * 64 * 2048 + ll * 512 + 256;
        u16* vtm = (u16*)(ws + OFF_VTMEM) + ((size_t)ll * 4096 + (size_t)(b * 4) * 64) * 256 + s0;
        vt_strip<4>([&](int hd) { return srow + hd * 64; }, 2048,
                    [&](int hd) { return vtm + (size_t)hd * 64 * 256; }, 256, T, tid);
      }
    }
  }
  const size_t gtid = (size_t)blockIdx.x * NTHR + tid;
  const size_t gn = (size_t)gridDim.x * NTHR;
  const float* c64 = (const float*)(ws + OFF_COS64); const float* s64 = (const float*)(ws + OFF_SIN64);
  const float* c32 = (const float*)(ws + OFF_COS32); const float* s32 = (const float*)(ws + OFF_SIN32);
  for (size_t i = gtid; i < (size_t)T_TOK * 24; i += gn) {
    const int tok = (int)(i / 24), u = (int)(i % 24);
    const int slot = u >> 2, c = u & 3;
    const int col0 = (slot < 4) ? (C_CQ + slot * 64) : (C_CK + (slot - 4) * 64);
    u16* p1 = proj + (size_t)tok * NP + col0 + 8 * c;
    const u32x4 a = *(const u32x4*)p1, b = *(const u32x4*)(p1 + 32);
    const f32x4 ca = *(const f32x4*)(c64 + (size_t)tok * 32 + 8 * c), cb = *(const f32x4*)(c64 + (size_t)tok * 32 + 8 * c + 4);
    const f32x4 sa = *(const f32x4*)(s64 + (size_t)tok * 32 + 8 * c), sb = *(const f32x4*)(s64 + (size_t)tok * 32 + 8 * c + 4);
    const float cs[8] = {ca.x, ca.y, ca.z, ca.w, cb.x, cb.y, cb.z, cb.w};
    const float sn[8] = {sa.x, sa.y, sa.z, sa.w, sb.x, sb.y, sb.z, sb.w};
    const unsigned aw_[4] = {a.x, a.y, a.z, a.w}, bw_[4] = {b.x, b.y, b.z, b.w};
    unsigned o1[4], o2[4];
#pragma unroll
    for (int j = 0; j < 4; ++j) {
      const float x1a = lo_f(aw_[j]), x1b = hi_f(aw_[j]), x2a = lo_f(bw_[j]), x2b = hi_f(bw_[j]);
      o1[j] = pack2(x1a * cs[2 * j] - x2a * sn[2 * j], x1b * cs[2 * j + 1] - x2b * sn[2 * j + 1]);
      o2[j] = pack2(x2a * cs[2 * j] + x1a * sn[2 * j], x2b * cs[2 * j + 1] + x1b * sn[2 * j + 1]);
    }
    *(u32x4*)p1 = mk4(o1[0], o1[1], o1[2], o1[3]);
    *(u32x4*)(p1 + 32) = mk4(o2[0], o2[1], o2[2], o2[3]);
  }
  u16* kB = (u16*)(ws + OFF_KB);
  for (size_t i = gtid; i < (size_t)T_TOK * 2; i += gn) {
    const int tok = (int)(i >> 1), c = (int)(i & 1);
    const u16* p1 = proj + (size_t)tok * NP + C_BKR + 8 * c;
    const u32x4 a = *(const u32x4*)p1, b = *(const u32x4*)(p1 + 16);
    const f32x4 ca = *(const f32x4*)(c32 + (size_t)tok * 16 + 8 * c), cb = *(const f32x4*)(c32 + (size_t)tok * 16 + 8 * c + 4);
    const f32x4 sa = *(const f32x4*)(s32 + (size_t)tok * 16 + 8 * c), sb = *(const f32x4*)(s32 + (size_t)tok * 16 + 8 * c + 4);
    const float cs[8] = {ca.x, ca.y, ca.z, ca.w, cb.x, cb.y, cb.z, cb.w};
    const float sn[8] = {sa.x, sa.y, sa.z, sa.w, sb.x, sb.y, sb.z, sb.w};
    const unsigned aw_[4] = {a.x, a.y, a.z, a.w}, bw_[4] = {b.x, b.y, b.z, b.w};
    unsigned o1[4], o2[4];
#pragma unroll
    for (int j = 0; j < 4; ++j) {
      const float x1a = lo_f(aw_[j]), x1b = hi_f(aw_[j]), x2a = lo_f(bw_[j]), x2b = hi_f(bw_[j]);
      o1[j] = pack2(x1a * cs[2 * j] - x2a * sn[2 * j], x1b * cs[2 * j + 1] - x2b * sn[2 * j + 1]);
      o2[j] = pack2(x2a * cs[2 * j] + x1a * sn[2 * j], x2b * cs[2 * j + 1] + x1b * sn[2 * j + 1]);
    }
#pragma unroll
    for (int hh = 0; hh < 4; ++hh) {
      u16* d = kB + (size_t)tok * 384 + hh * 96 + 64 + 8 * c;
      *(u32x4*)d = mk4(o1[0], o1[1], o1[2], o1[3]);
      *(u32x4*)(d + 16) = mk4(o2[0], o2[1], o2[2], o2[3]);
    }
  }
}

DI void phase_att(const Params& p, int l, int xcd, char* smem) {
  char* ws = p.ws;
  const int tid = opaque_tid();
  const int wave = __builtin_amdgcn_readfirstlane(tid >> 6);
  const u16* proj = (const u16*)(ws + OFF_PROJ);
  u16* gated = (u16*)(ws + OFF_GATED);
  float* biasl = (float*)(smem + SM_BIAS);
  for (int i = tid; i < 4 * 257; i += NTHR) biasl[i] = p.rel_bias[(size_t)l * 4 * 257 + i] * LOG2E;
  __syncthreads();
  WorkQ w = wq_init(p, l, 2, xcd, 512, smem);
  for (;;) {
    int q; const int u = wq_next(w, q);
    if (u < 0) break;
    AttnBlk ab{}; AttnWave aw{};
    aw.m_init = -1e30f; aw.l_init = 0.f;
    if (u < 128) {
      const int i2 = 15 - (u >> 3), pr = 8 * q + (u & 7), b = pr >> 2, hh = pr & 3;
      const int qb = 2 * i2 + (wave >> 2);
      const size_t tok0 = (size_t)b * SEQ + qb * 128 + (wave & 3) * 32;
      ab.k = (const u16*)(ws + OFF_KB) + (size_t)b * SEQ * 384 + hh * 96; ab.k_ld = 384;
      ab.vt = (const u16*)(ws + OFF_VTB) + ((size_t)b * 256 + hh * 64) * SEQ; ab.vt_ld = SEQ;
      ab.kt_begin = 0; ab.kt_end = 4 * i2 + 4; ab.c = 0;
      aw.q = (const u16*)(ws + OFF_QB) + tok0 * 384 + hh * 96; aw.q_ld = 384;
      aw.gate = proj + tok0 * NP + C_BG + hh * 64;
      aw.out = gated + tok0 * DM + 256 + hh * 64;
      aw.hoff = 0; aw.my_kt_end = 2 * qb + 1 + ((wave >> 1) & 1);
      attn_item<96, 1, 0>(ab, aw, smem, tid);
    } else if (u < 256) {
      const int it = u - 128;
      const int c = 63 - (it >> 1), b = 2 * q + (it & 1);
      const int head = wave >> 1;
      const size_t tok0 = (size_t)b * SEQ + c * 64 + (wave & 1) * 32;
      ab.k = proj + (size_t)b * SEQ * NP + C_AK; ab.k_ld = NP;
      ab.vt = (const u16*)(ws + OFF_VTA) + ((size_t)b * 256) * SEQ; ab.vt_ld = SEQ;
      ab.kt_begin = c - 8 < 0 ? 0 : c - 8; ab.kt_end = c + 1; ab.c = c;
      aw.q = proj + tok0 * NP + C_AQ + head * 64; aw.q_ld = NP;
      aw.gate = proj + tok0 * NP + C_AG + head * 64;
      aw.out = gated + tok0 * DM + head * 64;
      aw.hoff = head; aw.my_kt_end = c + 1;
      aw.bias = biasl + head * 257; aw.qi0 = (wave & 1) * 32;
      attn_item<64, 4, 1>(ab, aw, smem, tid);
    } else if (u < 384) {
      const int it = u - 256;
      const int c = it >> 1, b = 2 * q + (it & 1);
      const int head = wave >> 1;
      const size_t tok0 = (size_t)b * SEQ + c * 64 + (wave & 1) * 32;
      ab.k = (const u16*)(ws + OFF_KVMEM) + (size_t)(b * 256) * 2048 + l * 512; ab.k_ld = 2048;
      ab.vt = (const u16*)(ws + OFF_VTMEM) + ((size_t)l * 4096 + b * 256) * 256; ab.vt_ld = 256;
      ab.kt_begin = 0; ab.kt_end = 4; ab.c = 0;
      aw.q = proj + tok0 * NP + C_MQ + head * 64; aw.q_ld = NP;
      aw.gate = proj + tok0 * NP + C_MG + head * 64;
      aw.out = gated + tok0 * DM + 768 + head * 64;
      aw.hoff = head; aw.my_kt_end = 4;
      attn_item<64, 4, 0>(ab, aw, smem, tid);
    } else {
      const int it = u - 384;
      const int c = it >> 1, b = 2 * q + (it & 1);
      const int kvh = wave >> 2, head = 2 * kvh + ((wave >> 1) & 1);
      const size_t tok0 = (size_t)b * SEQ + c * 64 + (wave & 1) * 32;
      ab.k = proj + (size_t)b * SEQ * NP + C_CK; ab.k_ld = NP;
      ab.vt = (const u16*)(ws + OFF_VTC) + ((size_t)b * 128) * SEQ; ab.vt_ld = SEQ;
      ab.kt_begin = c - 2 < 0 ? 0 : c - 2; ab.kt_end = c + 1; ab.c = c;
      aw.q = proj + tok0 * NP + C_CQ + head * 64; aw.q_ld = NP;
      aw.gate = proj + tok0 * NP + C_CG + head * 64;
      aw.out = gated + tok0 * DM + 512 + head * 64;
      aw.hoff = kvh; aw.my_kt_end = c + 1;
      aw.m_init = p.sinks[l * 4 + head] * LOG2E;
      attn_item<64, 2, 2>(ab, aw, smem, tid);
    }
  }
}

DI void phase_ln(const Params& p, int l) {
  char* ws = p.ws;
  u16* xb = (u16*)(ws + OFF_XB);
  const int tid = opaque_tid();
  const int lane = tid & 63;
  const int gw = blockIdx.x * 8 + (tid >> 6), nw = gridDim.x * 8;
  const float* g = p.ln_g + l * DM; const float* bb = p.ln_b + l * DM;
  const float* xin = (l == 0) ? p.x : p.out;
  const u16* yb = (const u16*)(ws + OFF_PROJ);
  const float alpha = 1.681792830507429f;
  f32x4 gv[4], bv[4];
#pragma unroll
  for (int i = 0; i < 4; ++i) { gv[i] = *(const f32x4*)(g + i * 256 + lane * 4); bv[i] = *(const f32x4*)(bb + i * 256 + lane * 4); }
  for (int row0 = gw * 2; row0 < T_TOK; row0 += nw * 2) {
    f32x4 v[2][4]; u32x2 yv[2][4];
#pragma unroll
    for (int rr = 0; rr < 2; ++rr)
#pragma unroll
      for (int i = 0; i < 4; ++i) {
        v[rr][i] = __builtin_nontemporal_load((const f32x4*)(xin + (size_t)(row0 + rr) * DM + i * 256 + lane * 4));
        yv[rr][i] = __builtin_nontemporal_load((const u32x2*)(yb + (size_t)(row0 + rr) * DM + i * 256 + lane * 4));
      }
#pragma unroll
    for (int rr = 0; rr < 2; ++rr)
#pragma unroll
      for (int i = 0; i < 4; ++i) {
        v[rr][i].x = alpha * v[rr][i].x + lo_f(yv[rr][i].x); v[rr][i].y = alpha * v[rr][i].y + hi_f(yv[rr][i].x);
        v[rr][i].z = alpha * v[rr][i].z + lo_f(yv[rr][i].y); v[rr][i].w = alpha * v[rr][i].w + hi_f(yv[rr][i].y);
      }
#pragma unroll
    for (int rr = 0; rr < 2; ++rr) {
      float* rp = p.out + (size_t)(row0 + rr) * DM;
      float s = 0.f;
#pragma unroll
      for (int i = 0; i < 4; ++i) s += v[rr][i].x + v[rr][i].y + v[rr][i].z + v[rr][i].w;
#pragma unroll
      for (int o = 32; o >= 1; o >>= 1) s += __shfl_xor(s, o);
      const float mu = s * (1.0f / 1024.0f);
      float q = 0.f;
#pragma unroll
      for (int i = 0; i < 4; ++i) {
        v[rr][i].x -= mu; v[rr][i].y -= mu; v[rr][i].z -= mu; v[rr][i].w -= mu;
        q += v[rr][i].x * v[rr][i].x + v[rr][i].y * v[rr][i].y + v[rr][i].z * v[rr][i].z + v[rr][i].w * v[rr][i].w;
      }
#pragma unroll
      for (int o = 32; o >= 1; o >>= 1) q += __shfl_xor(q, o);
      const float rstd = rsqrtf(q * (1.0f / 1024.0f) + 1e-5f);
#pragma unroll
      for (int i = 0; i < 4; ++i) {
        f32x4 y;
        y.x = v[rr][i].x * rstd * gv[i].x + bv[i].x;
        y.y = v[rr][i].y * rstd * gv[i].y + bv[i].y;
        y.z = v[rr][i].z * rstd * gv[i].z + bv[i].z;
        y.w = v[rr][i].w * rstd * gv[i].w + bv[i].w;
        __builtin_nontemporal_store(y, (f32x4*)(rp + i * 256 + lane * 4));
        if (l + 1 < DEPTH) *(u32x2*)(xb + (size_t)(row0 + rr) * DM + i * 256 + lane * 4) = mk2(pack2(y.x, y.y), pack2(y.z, y.w));
      }
    }
  }
}

#define XB_TMO      128
#define XB_XCNT(j)  (256  + 64 * (j))
#define XB_XSUB(j)  (1280 + 64 * (j))
#define XB_XGEN(j)  (2304 + 64 * (j))
#define XB_TOP      3328
#define XB_TOPGEN   3392
#define XB_SPIN_CAP (1u << 22)
#define LAS __attribute__((address_space(3)))
DI unsigned xb_ld(unsigned* p) { return __hip_atomic_load(p, __ATOMIC_RELAXED, __HIP_MEMORY_SCOPE_AGENT); }
DI unsigned xb_add(unsigned* p, unsigned v) { return __hip_atomic_fetch_add(p, v, __ATOMIC_RELAXED, __HIP_MEMORY_SCOPE_AGENT); }
DI unsigned xb_xcc_id() { return (unsigned)__builtin_amdgcn_s_getreg((3 << 11) | 20) & 0xFu; }
#define XB_SPIN(cond, bar) do { unsigned _sp = 0; while (cond) { __builtin_amdgcn_s_sleep(1); \
    if ((++_sp & 255u) == 0u) { if (xb_ld(&(bar)[XB_TMO])) break; if (_sp > XB_SPIN_CAP) { atomicAdd(&(bar)[XB_TMO], 1u); break; } } } } while (0)
struct XcdBarrier { unsigned* bar; unsigned x; volatile LAS unsigned* st; unsigned rank; };
DI XcdBarrier xcd_barrier_post(unsigned* bar, volatile LAS unsigned* st) {
  XcdBarrier b; b.bar = bar; b.x = xb_xcc_id(); b.st = st;
  b.rank = 0u;
  if (threadIdx.x == 0) b.rank = xb_add(&bar[XB_XCNT(b.x)], 1u);
  return b;
}
DI void xcd_barrier_complete(unsigned* bar, unsigned x, unsigned& nloc, unsigned& nx) {
  const unsigned G = gridDim.x * gridDim.y * gridDim.z;
  unsigned sum, cnt, mine, sp = 0u;
  for (;;) {
    sum = 0u; cnt = 0u; mine = 0u;
#pragma unroll
    for (unsigned j = 0; j < 16; ++j) { const unsigned c = xb_ld(&bar[XB_XCNT(j)]); sum += c; cnt += (c > 0u) ? 1u : 0u; mine = (j == x) ? c : mine; }
    if (sum == G) break;
    __builtin_amdgcn_s_sleep(1);
    if ((++sp & 255u) == 0u) { if (xb_ld(&bar[XB_TMO])) break; if (sp > XB_SPIN_CAP) { atomicAdd(&bar[XB_TMO], 1u); break; } }
  }
  nloc = mine > 0u ? mine : 1u; nx = cnt > 0u ? cnt : 1u;
}
DI void xcd_barrier(const XcdBarrier& b) {
  asm volatile("s_waitcnt vmcnt(0)" ::: "memory");
  __syncthreads();
  if (threadIdx.x == 0) {
    unsigned* bar = b.bar;
    __builtin_amdgcn_s_waitcnt(0);
    unsigned nloc = b.st[0], nx = b.st[1];
    if (nloc == 0u) { xcd_barrier_complete(bar, b.x, nloc, nx); b.st[0] = nloc; b.st[1] = nx; }
    const unsigned old = xb_add(&bar[XB_XSUB(b.x)], 1u);
    const unsigned gen = old / nloc;
    if (old + 1u == (gen + 1u) * nloc) {
      __builtin_amdgcn_fence(__ATOMIC_RELEASE, "agent");
      asm volatile("s_waitcnt vmcnt(0)" ::: "memory");
      const unsigned og = xb_add(&bar[XB_TOP], 1u);
      const unsigned tg = og / nx;
      if (og + 1u == (tg + 1u) * nx) xb_add(&bar[XB_TOPGEN], 1u);
      else XB_SPIN(xb_ld(&bar[XB_TOPGEN]) == tg, bar);
      __builtin_amdgcn_fence(__ATOMIC_ACQUIRE, "agent");
      xb_add(&bar[XB_XGEN(b.x)], 1u);
      asm volatile("s_waitcnt vmcnt(0)" ::: "memory");
    } else {
      XB_SPIN(xb_ld(&bar[XB_XGEN(b.x)]) == gen, bar);
      __builtin_amdgcn_fence(__ATOMIC_ACQUIRE, "agent");
      asm volatile("s_waitcnt vmcnt(0)" ::: "memory");
    }
  }
  __syncthreads();
}

__global__ void __launch_bounds__(NTHR, 2) fwd_megakernel(Params p) {
  cg::grid_group grid = cg::this_grid();
  extern __shared__ __attribute__((aligned(16))) unsigned char shm[];
  char* smem = (char*)shm;
  pg8::PG8_LAS_T lds = (pg8::PG8_LAS_T)shm;
  if (threadIdx.x < 8) ((unsigned*)(smem + SM_XB))[threadIdx.x] = 0u;
  __syncthreads();
  XcdBarrier xb = xcd_barrier_post((unsigned*)(p.ws + OFF_BAR), (volatile LAS unsigned*)(smem + SM_XB));
  phase0(p, smem);
  if (p.use_cg_sync) grid.sync();
  xcd_barrier(xb);
  int cperm, xcd_arg;
  {
    unsigned* bar = (unsigned*)(p.ws + OFF_BAR);
    if (threadIdx.x == 0) {
      const unsigned G = gridDim.x; bool uni = (G % 8u) == 0u; unsigned sum = 0u;
      for (unsigned j = 0; j < 16; ++j) { const unsigned c = xb_ld(&bar[XB_XCNT(j)]); sum += c; if (j < 8 ? (c != G / 8u) : (c != 0u)) uni = false; }
      if (sum != G) uni = false;
      *(int*)(smem + SM_ITEM) = uni ? (int)(0x10000u | (xb.x + 8u * xb.rank)) : (int)blockIdx.x;
    }
    __syncthreads();
    const int packed = __builtin_amdgcn_readfirstlane(*(int*)(smem + SM_ITEM));
    cperm = packed & 0xffff;
    xcd_arg = (int)xb.x | ((packed >> 16) ? 0x100 : 0);
    __syncthreads();
  }
  for (int ph = 0; ph < DEPTH * 5; ++ph) {
    const int l = ph / 5, k = ph % 5;
    if (k == 0 || k == 3) {
      const int nsub = (k == 0 && l == 0) ? 2 : 1;
      for (int sub = 0; sub < nsub; ++sub) phase_gemm(p, l, (k == 3) ? 2 : sub, cperm, lds);
    } else if (k == 1) phase_b1(p, l, xcd_arg, smem);
    else if (k == 2) phase_att(p, l, xcd_arg, smem);
    else phase_ln(p, l);
    if (ph + 1 < DEPTH * 5) xcd_barrier(xb);
  }
}

extern "C" void kernel_launch(void* const* d_in, const int* in_sizes, int n_in, void* d_out,
                              int out_size, void* d_ws, size_t ws_size, hipStream_t stream) {
  static int grid_blocks = 0;
  if (!grid_blocks) {
    int dev = 0, cus = 0, per_cu = 0;
    (void)hipGetDevice(&dev);
    (void)hipDeviceGetAttribute(&cus, hipDeviceAttributeMultiprocessorCount, dev);
    if (hipFuncSetAttribute((const void*)fwd_megakernel, hipFuncAttributeMaxDynamicSharedMemorySize, SM_TOTAL) != hipSuccess) {
      fprintf(stderr, "kernel_launch: hipFuncSetAttribute failed (%d bytes of dynamic LDS)\n", SM_TOTAL); return; }
    if (hipOccupancyMaxActiveBlocksPerMultiprocessor(&per_cu, (const void*)fwd_megakernel, NTHR, SM_TOTAL) != hipSuccess || per_cu < 1) {
      fprintf(stderr, "kernel_launch: occupancy query failed\n"); return; }
    grid_blocks = cus;
  }
  if (ws_size < WS_NEEDED) { fprintf(stderr, "workspace too small: %zu < %zu\n", ws_size, (size_t)WS_NEEDED); return; }
  Params p{};
  p.x = (const float*)d_in[0]; p.mem = (const float*)d_in[1]; p.pos = (const int*)d_in[2];
  p.w_in = (const float*)d_in[3]; p.rel_bias = (const float*)d_in[4]; p.q_norm = (const float*)d_in[5];
  p.w_uq = (const float*)d_in[6]; p.kv_norm = (const float*)d_in[7]; p.w_ukv = (const float*)d_in[8];
  p.sinks = (const float*)d_in[9]; p.w_mem_kv = (const float*)d_in[10]; p.w_out = (const float*)d_in[11];
  p.ln_g = (const float*)d_in[12]; p.ln_b = (const float*)d_in[13];
  p.out = (float*)d_out; p.ws = (char*)d_ws; p.use_cg_sync = 0; p.pad_ = 0;
  (void)hipMemsetAsync((char*)d_ws + OFF_BAR, 0, ZERO_BYTES, stream);
  void* args[] = {&p};
  hipError_t e = hipLaunchCooperativeKernel((void*)fwd_megakernel, dim3(grid_blocks), dim3(NTHR), args, SM_TOTAL, stream);
  if (e != hipSuccess) fprintf(stderr, "cooperative launch failed: %s (grid %d)\n", hipGetErrorString(e), grid_blocks);
}
```

```cpp
#include <hip/hip_runtime.h>
#include <hip/hip_cooperative_groups.h>
#include <cstdio>
#include <type_traits>
namespace cg = cooperative_groups;

typedef unsigned short u16;
typedef short bf16x8 __attribute__((ext_vector_type(8)));
typedef float f32x16 __attribute__((ext_vector_type(16)));
typedef __bf16 bf16x2_t __attribute__((ext_vector_type(2)));
typedef float f32x2_t __attribute__((ext_vector_type(2)));
typedef unsigned u32x4 __attribute__((ext_vector_type(4)));
typedef unsigned u32x2 __attribute__((ext_vector_type(2)));
typedef float f32x4 __attribute__((ext_vector_type(4)));

#define DI __device__ __forceinline__
#define MFMA(a, b, c) __builtin_amdgcn_mfma_f32_32x32x16_bf16((a), (b), (c), 0, 0, 0)

constexpr int T_TOK = 65536;
constexpr int SEQ = 4096;
constexpr int NBATCH = 16;
constexpr int DM = 1024;
constexpr int NP = 3072;
constexpr int PW = 2912;
constexpr int DEPTH = 4;
constexpr int NTHR = 512;
constexpr int C_AQ = 0, C_AK = 256, C_AV = 512, C_AG = 768;
constexpr int C_CQ = 1024, C_CK = 1280, C_CV = 1408, C_CG = 1536;
constexpr int C_MQ = 1792, C_MG = 2048;
constexpr int C_BG = 2304, C_BCQ = 2560, C_BCKV = 2752, C_BKR = 2880;

constexpr float LOG2E = 1.4426950408889634f;
constexpr float QS64 = 0.125f * LOG2E;
constexpr float QS96 = 0.10206207261596575f * LOG2E;

constexpr size_t AL(size_t x) { return (x + 255) & ~(size_t)255; }
constexpr size_t OFF_WIN = 0;
constexpr size_t OFF_WOUT = OFF_WIN + AL((size_t)DEPTH * NP * DM * 2);
constexpr size_t OFF_WUQ = OFF_WOUT + AL((size_t)DEPTH * DM * DM * 2);
constexpr size_t OFF_WUKV = OFF_WUQ + AL((size_t)DEPTH * 384 * 192 * 2);
constexpr size_t OFF_WMKV = OFF_WUKV + AL((size_t)DEPTH * 512 * 128 * 2);
constexpr size_t OFF_MEMB = OFF_WMKV + AL((size_t)DEPTH * 512 * 1024 * 2);
constexpr size_t OFF_KVMEM = OFF_MEMB + AL((size_t)4096 * 1024 * 2);
constexpr size_t OFF_VTMEM = OFF_KVMEM + AL((size_t)4096 * 2048 * 2);
constexpr size_t OFF_COS64 = OFF_VTMEM + AL((size_t)DEPTH * 4096 * 256 * 2);
constexpr size_t OFF_SIN64 = OFF_COS64 + AL((size_t)T_TOK * 32 * 4);
constexpr size_t OFF_COS32 = OFF_SIN64 + AL((size_t)T_TOK * 32 * 4);
constexpr size_t OFF_SIN32 = OFF_COS32 + AL((size_t)T_TOK * 16 * 4);
constexpr size_t OFF_XB = OFF_SIN32 + AL((size_t)T_TOK * 16 * 4);
constexpr size_t OFF_PROJ = OFF_XB + AL((size_t)T_TOK * DM * 2);
constexpr size_t OFF_VTA = OFF_PROJ + AL((size_t)T_TOK * NP * 2);
constexpr size_t OFF_VTC = OFF_VTA + AL((size_t)T_TOK * 256 * 2);
constexpr size_t OFF_VTB = OFF_VTC + AL((size_t)T_TOK * 128 * 2);
constexpr size_t OFF_QB = OFF_VTB + AL((size_t)T_TOK * 256 * 2);
constexpr size_t OFF_KB = OFF_QB + AL((size_t)T_TOK * 384 * 2);
constexpr size_t OFF_GATED = OFF_KB + AL((size_t)T_TOK * 384 * 2);
constexpr size_t OFF_STATS = OFF_GATED + AL((size_t)T_TOK * DM * 2);
constexpr size_t OFF_BAR = OFF_STATS + AL((size_t)T_TOK * 2 * 4);
constexpr size_t BAR_BYTES = 3456 * 4;
constexpr size_t OFF_WQ = OFF_BAR + AL(BAR_BYTES);
constexpr size_t WQ_BYTES = (size_t)DEPTH * 4 * 8 * 64;
constexpr size_t ZERO_BYTES = (OFF_WQ + WQ_BYTES) - OFF_BAR;
constexpr size_t WS_NEEDED = OFF_WQ + WQ_BYTES;

constexpr int SM_STAGE_BYTES = 131072;
constexpr int GROW = 40;
constexpr int G_STAGE = 384 * GROW * 2;
constexpr int HALF_GEMM = 2 * G_STAGE;
constexpr int VROWB = 144;
constexpr int ATT_STAGE = 17408 + 128 * VROWB;
constexpr int HALF_ATT = 2 * ATT_STAGE;
constexpr int SM_K = 0;
constexpr int SM_VT = 17408;
constexpr int SM_BIAS = 2 * HALF_ATT;
constexpr int SM_RS = SM_BIAS + 4128;
constexpr int SM_XB = SM_RS + 2048;
constexpr int SM_ITEM = SM_XB + 16;
constexpr int SM_TOTAL = SM_ITEM + 16;

struct Params {
  const float* x; const float* mem; const int* pos;
  const float* w_in; const float* rel_bias; const float* q_norm; const float* w_uq;
  const float* kv_norm; const float* w_ukv; const float* sinks; const float* w_mem_kv;
  const float* w_out; const float* ln_g; const float* ln_b;
  float* out; char* ws;
};

DI float bf2f(u16 v) { return __uint_as_float(((unsigned)v) << 16); }
DI unsigned pack2(float a, float b) {
  f32x2_t v = {a, b};
  bf16x2_t r = __builtin_convertvector(v, bf16x2_t);
  return __builtin_bit_cast(unsigned, r);
}
DI u32x4 mk4(unsigned a, unsigned b, unsigned c, unsigned d) { u32x4 v = {a, b, c, d}; return v; }
DI u32x2 mk2(unsigned a, unsigned b) { u32x2 v = {a, b}; return v; }
DI int opaque_tid() { int t = threadIdx.x; asm volatile("" : "+v"(t)); return t; }
typedef const __attribute__((address_space(1))) char* gptr_t;
DI gptr_t uniform_ptr(const void* p) {
  const unsigned long long v = (unsigned long long)p;
  const unsigned lo = __builtin_amdgcn_readfirstlane((unsigned)v), hi = __builtin_amdgcn_readfirstlane((unsigned)(v >> 32));
  return (gptr_t)(((unsigned long long)hi << 32) | lo);
}
DI float lo_f(unsigned u) { return __uint_as_float(u << 16); }
DI float hi_f(unsigned u) { return __uint_as_float(u & 0xffff0000u); }
DI float fast_exp2(float x) { return __builtin_amdgcn_exp2f(x); }
DI float silu_f(float g) { return g * __builtin_amdgcn_rcpf(1.0f + fast_exp2(-g * LOG2E)); }

DI int win_colmap(int n, float& sc) {
  sc = 1.0f;
  if (n < 1024) { if (n < 256) sc = QS64; return n; }
  if (n < 1280) { sc = QS64; return 1632 + (n - 1024); }
  if (n < 1408) return 1888 + (n - 1280);
  if (n < 1536) return 2016 + (n - 1408);
  if (n < 1792) return 2144 + (n - 1536);
  if (n < 2048) { sc = QS64; return 2400 + (n - 1792); }
  if (n < 2304) return 2656 + (n - 2048);
  if (n < 2560) return 1376 + (n - 2304);
  if (n < 2752) return 1024 + (n - 2560);
  if (n < 2880) return 1216 + (n - 2752);
  if (n < 2912) return 1344 + (n - 2880);
  sc = 0.0f; return 0;
}

DI void transpose_tile(const Params& p, int l, int job, int kt, int nt, float* tile, int tid) {
  const float* src; int lds_; u16* dst; int ldd; const float* kscale = nullptr; float kconst = 1.0f;
  char* ws = p.ws;
  if (job == 0) { src = p.w_in + (size_t)l * DM * PW; lds_ = PW; dst = (u16*)(ws + OFF_WIN) + (size_t)l * NP * DM; ldd = DM; }
  else if (job == 1) { src = p.w_out + (size_t)l * DM * DM; lds_ = DM; dst = (u16*)(ws + OFF_WOUT) + (size_t)l * DM * DM; ldd = DM; }
  else if (job == 2) { src = p.w_uq + (size_t)l * 192 * 384; lds_ = 384; dst = (u16*)(ws + OFF_WUQ) + (size_t)l * 384 * 192; ldd = 192; kscale = p.q_norm + l * 192; kconst = QS96; }
  else if (job == 3) { src = p.w_ukv + (size_t)l * 128 * 512; lds_ = 512; dst = (u16*)(ws + OFF_WUKV) + (size_t)l * 512 * 128; ldd = 128; kscale = p.kv_norm + l * 128; }
  else { src = p.w_mem_kv + (size_t)l * 1024 * 512; lds_ = 512; dst = (u16*)(ws + OFF_WMKV) + (size_t)l * 512 * 1024; ldd = 1024; }
  const int k0 = kt * 64, n0 = nt * 64;
  {
    const int nx = tid & 63;
    const int n = n0 + nx;
    int col; float sc = 1.0f;
    if (job == 0) col = win_colmap(n, sc);
    else if (job == 2) col = (n < 256) ? ((n >> 6) * 96 + (n & 63)) : (((n - 256) >> 5) * 96 + 64 + ((n - 256) & 31));
    else if (job == 3) col = (n < 256) ? ((n >> 6) * 128 + (n & 63)) : (((n - 256) >> 6) * 128 + 64 + ((n - 256) & 63));
    else col = n;
    sc *= kconst;
    float v[16];
#pragma unroll
    for (int i = 0; i < 16; ++i) v[i] = __builtin_nontemporal_load(&src[(size_t)(k0 + i * 4 + (tid >> 6)) * lds_ + col]);
#pragma unroll
    for (int i = 0; i < 16; ++i) {
      const int ky = i * 4 + (tid >> 6);
      float x = v[i] * sc;
      if (kscale) x *= kscale[k0 + ky];
      tile[ky * 65 + nx] = x;
    }
  }
  __syncthreads();
  {
    const int n = tid >> 2, kc = (tid & 3) * 16;
    unsigned w[8];
#pragma unroll
    for (int i = 0; i < 8; ++i) w[i] = pack2(tile[(kc + 2 * i) * 65 + n], tile[(kc + 2 * i + 1) * 65 + n]);
    u32x4* d = (u32x4*)(dst + (size_t)(n0 + n) * ldd + k0 + kc);
    d[0] = mk4(w[0], w[1], w[2], w[3]);
    d[1] = mk4(w[4], w[5], w[6], w[7]);
  }
  __syncthreads();
}

DI void sincos_reduced(double ang, float& c, float& s) {
  const double TWO_PI = 6.283185307179586476925287;
  double k = rint(ang * (1.0 / TWO_PI));
  double r = fma(-k, TWO_PI, ang);
  double r2 = r * r;
  double sp = -1.0 / 15511210043330985984000000.0;
  double ss = 1.0 / 15511210043330985984000000.0;
  ss = fma(ss, r2, -1.0 / 25852016738884976640000.0);
  ss = fma(ss, r2, 1.0 / 51090942171709440000.0);
  ss = fma(ss, r2, -1.0 / 121645100408832000.0);
  ss = fma(ss, r2, 1.0 / 355687428096000.0);
  ss = fma(ss, r2, -1.0 / 1307674368000.0);
  ss = fma(ss, r2, 1.0 / 6227020800.0);
  ss = fma(ss, r2, -1.0 / 39916800.0);
  ss = fma(ss, r2, 1.0 / 362880.0);
  ss = fma(ss, r2, -1.0 / 5040.0);
  ss = fma(ss, r2, 1.0 / 120.0);
  ss = fma(ss, r2, -1.0 / 6.0);
  ss = fma(ss, r2, 1.0);
  ss *= r;
  (void)sp;
  double cc = 1.0 / 620448401733239439360000.0;
  cc = fma(cc, r2, -1.0 / 1124000727777607680000.0);
  cc = fma(cc, r2, 1.0 / 2432902008176640000.0);
  cc = fma(cc, r2, -1.0 / 6402373705728000.0);
  cc = fma(cc, r2, 1.0 / 20922789888000.0);
  cc = fma(cc, r2, -1.0 / 87178291200.0);
  cc = fma(cc, r2, 1.0 / 479001600.0);
  cc = fma(cc, r2, -1.0 / 3628800.0);
  cc = fma(cc, r2, 1.0 / 40320.0);
  cc = fma(cc, r2, -1.0 / 720.0);
  cc = fma(cc, r2, 1.0 / 24.0);
  cc = fma(cc, r2, -0.5);
  cc = fma(cc, r2, 1.0);
  c = (float)cc; s = (float)ss;
}

DI void phase0(const Params& p, char* smem) {
  const int tid = opaque_tid();
  const size_t gtid = (size_t)blockIdx.x * NTHR + tid;
  const size_t gn = (size_t)gridDim.x * NTHR;
  char* ws = p.ws;
  {
    u16* xb = (u16*)(ws + OFF_XB);
    const size_t n8 = (size_t)T_TOK * DM / 8;
    for (size_t i = gtid; i < n8; i += 4 * gn) {
      f32x4 a[4], b[4];
#pragma unroll
      for (int u = 0; u < 4; ++u) { const size_t k = (i + u * gn < n8) ? i + u * gn : i; a[u] = __builtin_nontemporal_load(&((const f32x4*)p.x)[2 * k]); b[u] = __builtin_nontemporal_load(&((const f32x4*)p.x)[2 * k + 1]); }
#pragma unroll
      for (int u = 0; u < 4; ++u) { const size_t k = (i + u * gn < n8) ? i + u * gn : i; ((u32x4*)xb)[k] = mk4(pack2(a[u].x, a[u].y), pack2(a[u].z, a[u].w), pack2(b[u].x, b[u].y), pack2(b[u].z, b[u].w)); }
    }
    u16* mb = (u16*)(ws + OFF_MEMB);
    const size_t m8 = (size_t)4096 * 1024 / 8;
    for (size_t i = gtid; i < m8; i += gn) {
      const f32x4 a = ((const f32x4*)p.mem)[2 * i], b = ((const f32x4*)p.mem)[2 * i + 1];
      ((u32x4*)mb)[i] = mk4(pack2(a.x, a.y), pack2(a.z, a.w), pack2(b.x, b.y), pack2(b.z, b.w));
    }
  }
  {
    float* c64 = (float*)(ws + OFF_COS64); float* s64 = (float*)(ws + OFF_SIN64);
    float* c32 = (float*)(ws + OFF_COS32); float* s32 = (float*)(ws + OFF_SIN32);
    const double L2T = 13.287712379549449;
    float* invf = (float*)(smem + 40960);
    if (tid < 48) invf[tid] = (tid < 32) ? (float)exp2(-(double)(2 * tid) / 64.0 * L2T) : (float)exp2(-(double)(2 * (tid - 32)) / 32.0 * L2T);
    __syncthreads();
    for (size_t i = gtid; i < (size_t)T_TOK * 48; i += gn) {
      const int tok = (int)(i / 48), j = (int)(i % 48);
      const float angf = (float)p.pos[tok] * invf[j];
      float c, s;
      sincos_reduced((double)angf, c, s);
      if (j < 32) { c64[(size_t)tok * 32 + j] = c; s64[(size_t)tok * 32 + j] = s; }
      else { c32[(size_t)tok * 16 + (j - 32)] = c; s32[(size_t)tok * 16 + (j - 32)] = s; }
    }
    __syncthreads();
  }
  {
    const int hf = tid >> 8, tidh = tid & 255;
    float* tile = (float*)(smem + hf * 16896);
    for (int t2 = blockIdx.x; t2 < DEPTH * 1186 / 2; t2 += gridDim.x) {
      const int t = 2 * t2 + hf;
      const int l = t / 1186; int u = t % 1186;
      int job, kt, nt;
      if (u < 768) { job = 0; kt = u / 48; nt = u % 48; }
      else if ((u -= 768) < 256) { job = 1; kt = u / 16; nt = u % 16; }
      else if ((u -= 256) < 18) { job = 2; kt = u / 6; nt = u % 6; }
      else if ((u -= 18) < 16) { job = 3; kt = u / 8; nt = u % 8; }
      else { u -= 16; job = 4; kt = u / 8; nt = u % 8; }
      transpose_tile(p, l, job, kt, nt, tile, tidh);
    }
  }
}

namespace pg8 {
#define PG8_LAS __attribute__((address_space(3)))
typedef unsigned short bf16_t;
typedef short bf16x8 __attribute__((ext_vector_type(8)));
typedef float f32x4 __attribute__((ext_vector_type(4)));
typedef unsigned u32x4 __attribute__((ext_vector_type(4)));
constexpr int BM = 256, BK = 64, HALF = 128, HTB = HALF * BK * 2  , STAGE_BYTES = 8 * HTB, NXCD = 8, WGM = 8;

__host__ __device__ __forceinline__ int lds_byte(int r, int c) { const int st = (r >> 4) * 2 + (c >> 5), rr = r & 15, cc = c & 31, ob = rr * 64 + cc * 2; return st * 1024 + (ob ^ (((ob >> 9) & 1) << 5)); }
__host__ __device__ __forceinline__ void stage_rc(int b, int& R, int& C) { const int st = b / 1024, sb = b % 1024, swz = sb ^ (((sb >> 9) & 1) << 5); R = (st >> 1) * 16 + swz / 64; C = (st & 1) * 32 + (swz % 64) / 2; }
__host__ __device__ __forceinline__ int perm32(int rho) { const int n = rho >> 4, i = rho & 15; return 8 * (i >> 2) + 4 * n + (i & 3); }

typedef PG8_LAS unsigned char* PG8_LAS_T;
struct Unit { int pm, pn; };
struct Gemm { const bf16_t* A; const bf16_t* Bt; int M, N, K; };

struct StaticOrder {
    int nM, nN, nwg, G, c;
    __host__ __device__ void init(int M, int N, int G_, int c_) { nM = M / BM; nN = N / BM; nwg = nM * nN; G = G_; c = c_; }
    __host__ __device__ bool next(int i, Unit& u) const {
        const long L = (long)i * G + c; if (L >= nwg) return false;
        int wgid = (int)L; { const int q = nwg / NXCD, r = nwg % NXCD, xcd = wgid % NXCD, off = wgid / NXCD; wgid = (xcd < r ? xcd * (q + 1) : r * (q + 1) + (xcd - r) * q) + off; }
        const int nig = WGM * nN, gid = wgid / nig, fm = gid * WGM, gsz = (nM - fm) < WGM ? (nM - fm) : WGM;
        u.pm = fm + ((wgid % nig) % gsz); u.pn = (wgid % nig) / gsz; return true;
    }
    __device__ __forceinline__ void a_ready(const Unit&) const {}
    __device__ __forceinline__ void done(const Unit&) const {}
};
__device__ __forceinline__ unsigned cvt_pk_bf16(float lo, float hi) { unsigned r; asm volatile("v_cvt_pk_bf16_f32 %0, %1, %2" : "=v"(r) : "v"(lo), "v"(hi)); return r; }

struct EpiBf16 {
    static constexpr bool PERM = true, AFTER_DRAIN = false;
    bf16_t* O; int ldc; int nt;
    __device__ __forceinline__ void operator()(const f32x4 (&acc)[2][2][4][2], const Unit& u, int wr, int wc, int fr, int fq) const {
        const int row0 = u.pm * BM + wr * 64 + fr; const int col0 = u.pn * BM + wc * 32 + 8 * fq;
#pragma unroll
        for (int ai = 0; ai < 2; ++ai)
#pragma unroll
            for (int m = 0; m < 4; ++m) { bf16_t* rowp = O + (size_t)(row0 + ai * HALF + m * 16) * ldc + col0;
#pragma unroll
                for (int bj = 0; bj < 2; ++bj) { const f32x4 v0 = acc[ai][bj][m][0], v1 = acc[ai][bj][m][1];
                    u32x4 w; w.x = cvt_pk_bf16(v0[0], v0[1]); w.y = cvt_pk_bf16(v0[2], v0[3]); w.z = cvt_pk_bf16(v1[0], v1[1]); w.w = cvt_pk_bf16(v1[2], v1[3]);
                    if (nt) __builtin_nontemporal_store(w, (u32x4*)(rowp + bj * HALF)); else *(u32x4*)(rowp + bj * HALF) = w; } }
    }
};
template <bool LN> struct EpiRes {
    static constexpr bool PERM = false, AFTER_DRAIN = false;
    static constexpr float alpha = 1.681792830507429f;
    const float* base; float* out; int ldc; const float* stats; const float* g; const float* b;
    __device__ __forceinline__ void operator()(const f32x4 (&acc)[2][2][4][2], const Unit& u, int wr, int wc, int fr, int fq) const {
        const int row0 = u.pm * BM + wr * 64 + fr, col0 = u.pn * BM + wc * 32 + 4 * fq;
        f32x4 gv[2][2], bv[2][2];
        if constexpr (LN) {
#pragma unroll
            for (int bj = 0; bj < 2; ++bj)
#pragma unroll
                for (int n = 0; n < 2; ++n) { gv[bj][n] = *(const f32x4*)(g + col0 + bj * HALF + n * 16) * alpha; bv[bj][n] = *(const f32x4*)(b + col0 + bj * HALF + n * 16) * alpha; }
        }
#pragma unroll
        for (int ai = 0; ai < 2; ++ai)
#pragma unroll
            for (int m = 0; m < 4; ++m) { const int row = row0 + ai * HALF + m * 16; const size_t off = (size_t)row * ldc + col0;
                f32x4 bs[2][2];
#pragma unroll
                for (int bj = 0; bj < 2; ++bj)
#pragma unroll
                    for (int n = 0; n < 2; ++n) bs[bj][n] = *(const f32x4*)(base + off + bj * HALF + n * 16);
                if constexpr (LN) {
                    const float mean = stats[2 * row], rstd = stats[2 * row + 1];
#pragma unroll
                    for (int bj = 0; bj < 2; ++bj)
#pragma unroll
                        for (int n = 0; n < 2; ++n) *(f32x4*)(out + off + bj * HALF + n * 16) = (bs[bj][n] - mean) * rstd * gv[bj][n] + bv[bj][n] + acc[ai][bj][m][n];
                } else {
#pragma unroll
                    for (int bj = 0; bj < 2; ++bj)
#pragma unroll
                        for (int n = 0; n < 2; ++n) *(f32x4*)(out + off + bj * HALF + n * 16) = bs[bj][n] * alpha + acc[ai][bj][m][n];
                }
                asm volatile("" ::: "memory"); }
    }
};

template <class Epi, class Sched, bool STAMP = false>
__device__ __forceinline__ void gemm_phase(PG8_LAS unsigned char* lds, const Gemm g, const Sched& S, const Epi& E, unsigned long long* stamps) {
    int tid = threadIdx.x; asm volatile("" : "+v"(tid));
    const int wid = __builtin_amdgcn_readfirstlane(tid >> 6), lane = tid & 63, wr = wid >> 2, wc = wid & 3, fr = lane & 15, fq = lane >> 4;
    const int K = g.K, nt = K / BK;
    int ts_lo = 0, ts_hi = 0, nts = 0; const unsigned long long rt_entry = STAMP ? (unsigned long long)wall_clock64() : 0ull;
#define PG8_STAMP() do { if (STAMP && wid == 0 && nts < 64) { const unsigned long long _c = (unsigned long long)clock64(); \
        ts_lo = (lane == nts) ? (int)(unsigned)_c : ts_lo; ts_hi = (lane == nts) ? (int)(unsigned)(_c >> 32) : ts_hi; ++nts; } } while (0)
    PG8_STAMP();
    unsigned voffA[2], voffB[2];
#pragma unroll
    for (int i = 0; i < 2; ++i) { int R, C; stage_rc(tid * 16 + i * 8192, R, C); const int Rb = Epi::PERM ? ((R & ~31) + perm32(R & 31)) : R;
        voffA[i] = (unsigned)(R * K + C) * 2u; voffB[i] = (unsigned)(Rb * K + C) * 2u; }
    const size_t kstep = (size_t)(BK * 2);
    const size_t hstep = (size_t)HALF * K * 2;
    const size_t tstep = 2 * hstep;
    const unsigned ldsw = (unsigned)wid * 1024u;
    const int aoff = lds_byte(wr * 64 + fr, fq * 8), boff = lds_byte(wc * 32 + fr, fq * 8);
#define PG8_SA(b, h) (((b) * 2 + (h)) * HTB)
#define PG8_SB(b, h) ((4 + (b) * 2 + (h)) * HTB)
#define PG8_STAGE(bufoff, gbase, voff) do { _Pragma("unroll") for (int _i = 0; _i < 2; ++_i) \
        __builtin_amdgcn_global_load_lds((const unsigned*)((const char*)(gbase) + (voff)[_i]), (PG8_LAS unsigned*)(lds + (bufoff) + ldsw + _i * 8192), 16, 0, 0); } while (0)
#define PG8_LDA(dst, b, h) do { _Pragma("unroll") for (int m = 0; m < 4; ++m) _Pragma("unroll") for (int k = 0; k < 2; ++k) dst[m][k] = *(const PG8_LAS bf16x8*)(lds + PG8_SA(b, h) + aoff + m * 2048 + k * 1024); } while (0)
#define PG8_LDB(dst, b, h) do { _Pragma("unroll") for (int n = 0; n < 2; ++n) _Pragma("unroll") for (int k = 0; k < 2; ++k) dst[n][k] = *(const PG8_LAS bf16x8*)(lds + PG8_SB(b, h) + boff + n * 2048 + k * 1024); } while (0)
#define PG8_MMA(ai, bj, At, Bt) do { __builtin_amdgcn_s_setprio(1); _Pragma("unroll") for (int m = 0; m < 4; ++m) _Pragma("unroll") for (int n = 0; n < 2; ++n) _Pragma("unroll") for (int k = 0; k < 2; ++k) \
        acc[ai][bj][m][n] = __builtin_amdgcn_mfma_f32_16x16x32_bf16(Bt[n][k], At[m][k], acc[ai][bj][m][n], 0, 0, 0); __builtin_amdgcn_s_setprio(0); } while (0)
#define PG8_WAIT_V(n) asm volatile("s_waitcnt vmcnt(" #n ")" ::: "memory")
#define PG8_WAIT_L(n) asm volatile("s_waitcnt lgkmcnt(" #n ")" ::: "memory")
#define PG8_BAR __builtin_amdgcn_s_barrier()
#define PG8_SCHED __builtin_amdgcn_sched_barrier(0)
    Unit cur, nxt; int ui = 0;
    if (!S.next(0, cur)) return;
    f32x4 acc[2][2][4][2];
#pragma unroll
    for (int a = 0; a < 2; ++a)
#pragma unroll
        for (int b = 0; b < 2; ++b)
#pragma unroll
            for (int m = 0; m < 4; ++m)
#pragma unroll
                for (int n = 0; n < 2; ++n) acc[a][b][m][n] = (f32x4){0.f, 0.f, 0.f, 0.f};
    bf16x8 At[4][2], B0[2][2], B1[2][2];
    const char* cA = (const char*)g.A + (size_t)cur.pm * tstep; const char* cB = (const char*)g.Bt + (size_t)cur.pn * tstep;
    S.a_ready(cur);
    PG8_STAGE(PG8_SB(0, 0), cB, voffB); PG8_STAGE(PG8_SA(0, 0), cA, voffA); PG8_STAGE(PG8_SB(0, 1), cB + hstep, voffB); PG8_STAGE(PG8_SA(0, 1), cA + hstep, voffA);
    if (wr == 1) PG8_BAR;
    PG8_WAIT_V(4); PG8_BAR;
    PG8_STAGE(PG8_SB(1, 0), cB + kstep, voffB); PG8_STAGE(PG8_SA(1, 0), cA + kstep, voffA); PG8_STAGE(PG8_SB(1, 1), cB + hstep + kstep, voffB);
    PG8_WAIT_V(6); PG8_BAR;
    PG8_STAMP();
    for (;;) {
        const bool has_next = S.next(ui + 1, nxt);
        const char* nA = has_next ? (const char*)g.A + (size_t)nxt.pm * tstep : cA; const char* nB = has_next ? (const char*)g.Bt + (size_t)nxt.pn * tstep : cB;
        for (int t = 0; t < nt; t += 2) {
            const bool last = (t == nt - 2);
            const char* a1 = cA + (size_t)(t + 1) * kstep;
            const char* a2 = last ? nA : cA + (size_t)(t + 2) * kstep; const char* b2 = last ? nB : cB + (size_t)(t + 2) * kstep;
            const char* a3 = a2 + kstep; const char* b3 = b2 + kstep;
            if (last && has_next) S.a_ready(nxt);
            PG8_LDB(B0, 0, 0); PG8_SCHED; PG8_LDA(At, 0, 0); PG8_STAGE(PG8_SA(1, 1), a1 + hstep, voffA);
            PG8_WAIT_L(8); PG8_BAR; PG8_WAIT_L(0); PG8_MMA(0, 0, At, B0); PG8_BAR; PG8_SCHED;
            PG8_LDB(B1, 0, 1); PG8_STAGE(PG8_SB(0, 0), b2, voffB);
            PG8_BAR; PG8_WAIT_L(0); PG8_MMA(0, 1, At, B1); PG8_BAR;
            PG8_LDA(At, 0, 1); PG8_STAGE(PG8_SA(0, 0), a2, voffA);
            PG8_BAR; PG8_WAIT_L(0); PG8_MMA(1, 0, At, B0); PG8_BAR; PG8_SCHED;
            PG8_STAGE(PG8_SB(0, 1), b2 + hstep, voffB);
            PG8_WAIT_V(6); PG8_BAR; PG8_MMA(1, 1, At, B1); PG8_BAR;
            PG8_LDB(B0, 1, 0); PG8_SCHED; PG8_LDA(At, 1, 0); PG8_STAGE(PG8_SA(0, 1), a2 + hstep, voffA);
            PG8_WAIT_L(8); PG8_BAR; PG8_WAIT_L(0); PG8_MMA(0, 0, At, B0); PG8_BAR; PG8_SCHED;
            PG8_LDB(B1, 1, 1); PG8_STAGE(PG8_SB(1, 0), b3, voffB);
            PG8_BAR; PG8_WAIT_L(0); PG8_MMA(0, 1, At, B1); PG8_BAR;
            PG8_LDA(At, 1, 1); PG8_STAGE(PG8_SA(1, 0), a3, voffA);
            PG8_BAR; PG8_WAIT_L(0); PG8_MMA(1, 0, At, B0); PG8_BAR; PG8_SCHED;
            PG8_STAGE(PG8_SB(1, 1), b3 + hstep, voffB);
            PG8_WAIT_V(6); PG8_BAR; PG8_MMA(1, 1, At, B1); PG8_BAR;
        }
        PG8_STAMP();
        if constexpr (!Epi::AFTER_DRAIN) { E(acc, cur, wr, wc, fr, fq); S.done(cur); }
        PG8_STAMP();
        if (!has_next) break;
#pragma unroll
        for (int a = 0; a < 2; ++a)
#pragma unroll
            for (int b = 0; b < 2; ++b)
#pragma unroll
                for (int m = 0; m < 4; ++m)
#pragma unroll
                    for (int n = 0; n < 2; ++n) acc[a][b][m][n] = (f32x4){0.f, 0.f, 0.f, 0.f};
        cur = nxt; cA = nA; cB = nB; ++ui;
    }
    PG8_WAIT_V(0);
    if (wr == 0) PG8_BAR;
    PG8_BAR;
    if constexpr (Epi::AFTER_DRAIN) { E.fused(acc, cur, wr, wc, fr, fq, lds, wid, lane); S.done(cur); }
    PG8_STAMP();
    if (STAMP && wid == 0) { stamps[lane] = lane < nts ? (((unsigned long long)(unsigned)ts_hi << 32) | (unsigned)ts_lo) : 0ull;
        if (lane == 62) stamps[62] = rt_entry; if (lane == 63) stamps[63] = (unsigned long long)wall_clock64(); }
#undef PG8_STAMP
#undef PG8_SA
#undef PG8_SB
#undef PG8_STAGE
#undef PG8_LDA
#undef PG8_LDB
#undef PG8_MMA
#undef PG8_WAIT_V
#undef PG8_WAIT_L
#undef PG8_BAR
#undef PG8_SCHED
}
}

enum { M_ROW = 0, M_TR = 1, M_UQ = 2, M_UKVK = 3, M_UKVV = 4, M_G3 = 5 };

struct Epi {
  u16* out; int out_ld;
  u16* vt; int seq; int nseg0; int hrows;
  const float* c32; const float* s32;
  const float* xprev; float* xout;
};

template <int MODE>
DI void gemm_tile(const u16* __restrict__ A, int lda, const u16* __restrict__ Bt, int ldb, int K,
                          int m0, int n0, const Epi& e, char* smem, const float* rs, const int tid_in) {
  int tid = tid_in; asm volatile("" : "+v"(tid));
  constexpr bool SWAP = (MODE == M_ROW || MODE == M_UQ || MODE == M_UKVK || MODE == M_G3);
  const int lane = tid & 63, wave = tid >> 6, r = lane & 31, h = lane >> 5;
  const int wm = wave >> 1, wn = wave & 1;
  f32x16 acc[4][2];
#pragma unroll
  for (int i = 0; i < 4; ++i)
#pragma unroll
    for (int j = 0; j < 2; ++j)
#pragma unroll
      for (int q = 0; q < 16; ++q) acc[i][j][q] = 0.f;

  const int lrow = tid >> 2, lch = (tid & 3) * 8;
  const u16* Ag = A + (size_t)(m0 + lrow) * lda + lch;
  const u16* Bg = Bt + (size_t)(n0 + lrow) * ldb + lch;
  u16* Aw = (u16*)smem + lrow * GROW + lch;
  const u16* Ar = (const u16*)smem + (wm * 128 + r) * GROW + 8 * h;
  const u16* Br = (const u16*)smem + (256 + wn * 64 + r) * GROW + 8 * h;
  constexpr int STG = G_STAGE / 2;
  u32x4 r0[6], r1[6];
  const int KT = K >> 5;
#define G_LOAD(R, kt_) { const int k0_ = (kt_) * 32; \
    _Pragma("unroll") for (int i = 0; i < 4; ++i) R[i] = *(const u32x4*)(Ag + (size_t)(64 * i) * lda + k0_); \
    _Pragma("unroll") for (int i = 0; i < 2; ++i) R[4 + i] = *(const u32x4*)(Bg + (size_t)(64 * i) * ldb + k0_); }
#define G_WRITE(R, st_) { \
    _Pragma("unroll") for (int i = 0; i < 4; ++i) *(u32x4*)(Aw + (st_) * STG + (64 * i) * GROW) = R[i]; \
    _Pragma("unroll") for (int i = 0; i < 2; ++i) *(u32x4*)(Aw + (st_) * STG + (256 + 64 * i) * GROW) = R[4 + i]; }
#define G_COMPUTE(st_) { \
    _Pragma("unroll") for (int ks = 0; ks < 2; ++ks) { \
      bf16x8 af[4], bfr[2]; \
      _Pragma("unroll") for (int mb = 0; mb < 4; ++mb) af[mb] = *(const bf16x8*)(Ar + (st_) * STG + mb * 32 * GROW + ks * 16); \
      _Pragma("unroll") for (int nb = 0; nb < 2; ++nb) bfr[nb] = *(const bf16x8*)(Br + (st_) * STG + nb * 32 * GROW + ks * 16); \
      _Pragma("unroll") for (int mb = 0; mb < 4; ++mb) \
        _Pragma("unroll") for (int nb = 0; nb < 2; ++nb) { \
          if (SWAP) acc[mb][nb] = MFMA(bfr[nb], af[mb], acc[mb][nb]); \
          else acc[mb][nb] = MFMA(af[mb], bfr[nb], acc[mb][nb]); } } }
  G_LOAD(r0, 0);
  G_LOAD(r1, 1);
  G_WRITE(r0, 0);
  __syncthreads();
  for (int kt = 0; kt < KT; kt += 2) {
    { const int kn = (kt + 2 < KT) ? kt + 2 : KT - 1; G_LOAD(r0, kn); }
    __builtin_amdgcn_sched_barrier(0);
    G_COMPUTE(0);
    __builtin_amdgcn_sched_barrier(0);
    G_WRITE(r1, 1);
    __syncthreads();
    { const int kn = (kt + 3 < KT) ? kt + 3 : KT - 1; G_LOAD(r1, kn); }
    __builtin_amdgcn_sched_barrier(0);
    G_COMPUTE(1);
    __builtin_amdgcn_sched_barrier(0);
    G_WRITE(r0, 0);
    __syncthreads();
  }
#undef G_LOAD
#undef G_WRITE
#undef G_COMPUTE

  if (MODE == M_G3) {
    const float alpha = 1.681792830507429f;
#pragma unroll
    for (int mb = 0; mb < 4; ++mb) {
      const int m = m0 + wm * 128 + mb * 32 + r;
      const float* xp = e.xprev + (size_t)m * DM + n0 + wn * 64 + 4 * h;
      float* op = e.xout + (size_t)m * DM + n0 + wn * 64 + 4 * h;
      f32x4 xv[2][4];
#pragma unroll
      for (int nb = 0; nb < 2; ++nb)
#pragma unroll
        for (int g = 0; g < 4; ++g) xv[nb][g] = *(const f32x4*)(xp + nb * 32 + 8 * g);
#pragma unroll
      for (int nb = 0; nb < 2; ++nb)
#pragma unroll
        for (int g = 0; g < 4; ++g) {
          f32x4 o;
          o.x = alpha * xv[nb][g].x + acc[mb][nb][4 * g];
          o.y = alpha * xv[nb][g].y + acc[mb][nb][4 * g + 1];
          o.z = alpha * xv[nb][g].z + acc[mb][nb][4 * g + 2];
          o.w = alpha * xv[nb][g].w + acc[mb][nb][4 * g + 3];
          *(f32x4*)(op + nb * 32 + 8 * g) = o;
        }
    }
  } else if (SWAP) {
#pragma unroll
    for (int mb = 0; mb < 4; ++mb) {
      const int ml = wm * 128 + mb * 32 + r;
      const int m = m0 + ml;
      f32x4 rcs[2], rsn[2];
      if (MODE == M_UQ) {
        if (n0 >= 256) {
#pragma unroll
          for (int g = 0; g < 2; ++g) {
            rcs[g] = *(const f32x4*)(e.c32 + (size_t)m * 16 + 8 * g + 4 * h);
            rsn[g] = *(const f32x4*)(e.s32 + (size_t)m * 16 + 8 * g + 4 * h);
          }
        }
      }
      float rsv = 1.0f;
      if (MODE == M_UQ || MODE == M_UKVK) rsv = rs[ml];
#pragma unroll
      for (int nb = 0; nb < 2; ++nb) {
        const int nbase = n0 + wn * 64 + nb * 32;
        if (MODE == M_ROW) {
#pragma unroll
          for (int g = 0; g < 4; ++g) {
            const int n = nbase + 8 * g + 4 * h;
            u32x2 v = mk2(pack2(acc[mb][nb][4 * g], acc[mb][nb][4 * g + 1]), pack2(acc[mb][nb][4 * g + 2], acc[mb][nb][4 * g + 3]));
            *(u32x2*)(e.out + (size_t)m * e.out_ld + n) = v;
          }
        } else if (MODE == M_UKVK) {
#pragma unroll
          for (int g = 0; g < 4; ++g) {
            const int n = nbase + 8 * g + 4 * h;
            u32x2 v = mk2(pack2(acc[mb][nb][4 * g] * rsv, acc[mb][nb][4 * g + 1] * rsv), pack2(acc[mb][nb][4 * g + 2] * rsv, acc[mb][nb][4 * g + 3] * rsv));
            *(u32x2*)(e.out + (size_t)m * 384 + (n >> 6) * 96 + (n & 63)) = v;
          }
        } else if (MODE == M_UQ) {
          if (n0 < 256) {
#pragma unroll
            for (int g = 0; g < 4; ++g) {
              const int n = nbase + 8 * g + 4 * h;
              u32x2 v = mk2(pack2(acc[mb][nb][4 * g] * rsv, acc[mb][nb][4 * g + 1] * rsv), pack2(acc[mb][nb][4 * g + 2] * rsv, acc[mb][nb][4 * g + 3] * rsv));
              *(u32x2*)(e.out + (size_t)m * 384 + (n >> 6) * 96 + (n & 63)) = v;
            }
          } else {
            const int head = wn * 2 + nb;
#pragma unroll
            for (int g = 0; g < 2; ++g) {
              const int d = 8 * g + 4 * h;
              const f32x4 cs = rcs[g];
              const f32x4 sn = rsn[g];
              const float c_[4] = {cs.x, cs.y, cs.z, cs.w}, s_[4] = {sn.x, sn.y, sn.z, sn.w};
              float o1[4], o2[4];
#pragma unroll
              for (int j = 0; j < 4; ++j) {
                const float x1 = acc[mb][nb][4 * g + j] * rsv, x2 = acc[mb][nb][4 * (g + 2) + j] * rsv;
                o1[j] = x1 * c_[j] - x2 * s_[j];
                o2[j] = x2 * c_[j] + x1 * s_[j];
              }
              u16* dst = e.out + (size_t)m * 384 + head * 96 + 64 + d;
              *(u32x2*)dst = mk2(pack2(o1[0], o1[1]), pack2(o1[2], o1[3]));
              *(u32x2*)(dst + 16) = mk2(pack2(o2[0], o2[1]), pack2(o2[2], o2[3]));
            }
          }
        } else if (MODE == M_G3) {
        }
      }
    }
  } else {
    const int b = m0 / e.seq, s0 = m0 % e.seq;
#pragma unroll
    for (int nb = 0; nb < 2; ++nb) {
      const int n = n0 + wn * 64 + nb * 32 + r;
      u16* rowp = e.vt + ((size_t)b * e.hrows + (n - e.nseg0)) * e.seq + s0;
#pragma unroll
      for (int mb = 0; mb < 4; ++mb) {
#pragma unroll
        for (int g = 0; g < 4; ++g) {
          const int ml = wm * 128 + mb * 32 + 8 * g + 4 * h;
          float v0 = acc[mb][nb][4 * g], v1 = acc[mb][nb][4 * g + 1], v2 = acc[mb][nb][4 * g + 2], v3 = acc[mb][nb][4 * g + 3];
          if (MODE == M_UKVV) {
            const f32x4 rv = *(const f32x4*)(rs + ml);
            v0 *= rv.x; v1 *= rv.y; v2 *= rv.z; v3 *= rv.w;
          }
          *(u32x2*)(rowp + ml) = mk2(pack2(v0, v1), pack2(v2, v3));
        }
      }
    }
  }
}

template <int MODE, int KT>
DI void mla_tile8(const u16* __restrict__ Bt, int ldb, int m0, int n0, const Epi& e, char* smem, const float* rs, const int tid_in) {
  int tid = tid_in; asm volatile("" : "+v"(tid));
  constexpr bool SWAP = (MODE == M_ROW || MODE == M_UQ || MODE == M_UKVK || MODE == M_G3);
  const int lane = tid & 63, wave = tid >> 6, r = lane & 31, h = lane >> 5;
  const int wm = wave >> 1, wn = wave & 1;
  f32x16 acc[2][2];
#pragma unroll
  for (int i = 0; i < 2; ++i)
#pragma unroll
    for (int j = 0; j < 2; ++j)
#pragma unroll
      for (int q = 0; q < 16; ++q) acc[i][j][q] = 0.f;
  constexpr int A_STEP = 256 * GROW;
  constexpr int B_STG = 128 * GROW;
  const int lrow = tid >> 2, lch = (tid & 3) * 8;
  const u16* Bg = Bt + (size_t)(n0 + lrow) * ldb + lch;
  u16* Bw = (u16*)smem + KT * A_STEP + lrow * GROW + lch;
  const u16* Ar = (const u16*)smem + (wm * 64 + r) * GROW + 8 * h;
  const u16* Br = (const u16*)smem + KT * A_STEP + (wn * 64 + r) * GROW + 8 * h;
  u32x4 rb[KT];
#pragma unroll
  for (int kt = 0; kt < KT; ++kt) rb[kt] = *(const u32x4*)(Bg + kt * 32);
  *(u32x4*)(Bw) = rb[0];
  __syncthreads();
#pragma unroll
  for (int kt = 0; kt < KT; ++kt) {
    if (kt + 1 < KT) *(u32x4*)(Bw + ((kt + 1) & 1) * B_STG) = rb[kt + 1];
#pragma unroll
    for (int ks = 0; ks < 2; ++ks) {
      bf16x8 af[2], bfr[2];
#pragma unroll
      for (int mb = 0; mb < 2; ++mb) af[mb] = *(const bf16x8*)(Ar + kt * A_STEP + mb * 32 * GROW + ks * 16);
#pragma unroll
      for (int nb = 0; nb < 2; ++nb) bfr[nb] = *(const bf16x8*)(Br + (kt & 1) * B_STG + nb * 32 * GROW + ks * 16);
#pragma unroll
      for (int mb = 0; mb < 2; ++mb)
#pragma unroll
        for (int nb = 0; nb < 2; ++nb) {
          if (SWAP) acc[mb][nb] = MFMA(bfr[nb], af[mb], acc[mb][nb]);
          else acc[mb][nb] = MFMA(af[mb], bfr[nb], acc[mb][nb]);
        }
    }
    __syncthreads();
  }

  if (MODE == M_G3) {
    const float alpha = 1.681792830507429f;
#pragma unroll
    for (int mb = 0; mb < 2; ++mb) {
      const int m = m0 + wm * 64 + mb * 32 + r;
      const float* xp = e.xprev + (size_t)m * DM + n0 + wn * 64 + 4 * h;
      float* op = e.xout + (size_t)m * DM + n0 + wn * 64 + 4 * h;
      f32x4 xv[2][4];
#pragma unroll
      for (int nb = 0; nb < 2; ++nb)
#pragma unroll
        for (int g = 0; g < 4; ++g) xv[nb][g] = *(const f32x4*)(xp + nb * 32 + 8 * g);
#pragma unroll
      for (int nb = 0; nb < 2; ++nb)
#pragma unroll
        for (int g = 0; g < 4; ++g) {
          f32x4 o;
          o.x = alpha * xv[nb][g].x + acc[mb][nb][4 * g];
          o.y = alpha * xv[nb][g].y + acc[mb][nb][4 * g + 1];
          o.z = alpha * xv[nb][g].z + acc[mb][nb][4 * g + 2];
          o.w = alpha * xv[nb][g].w + acc[mb][nb][4 * g + 3];
          *(f32x4*)(op + nb * 32 + 8 * g) = o;
        }
    }
  } else if (SWAP) {
#pragma unroll
    for (int mb = 0; mb < 2; ++mb) {
      const int ml = wm * 64 + mb * 32 + r;
      const int m = m0 + ml;
      f32x4 rcs[2], rsn[2];
      if (MODE == M_UQ) {
        if (n0 >= 256) {
#pragma unroll
          for (int g = 0; g < 2; ++g) {
            rcs[g] = *(const f32x4*)(e.c32 + (size_t)m * 16 + 8 * g + 4 * h);
            rsn[g] = *(const f32x4*)(e.s32 + (size_t)m * 16 + 8 * g + 4 * h);
          }
        }
      }
      float rsv = 1.0f;
      if (MODE == M_UQ || MODE == M_UKVK) rsv = rs[ml];
#pragma unroll
      for (int nb = 0; nb < 2; ++nb) {
        const int nbase = n0 + wn * 64 + nb * 32;
        if (MODE == M_ROW) {
#pragma unroll
          for (int g = 0; g < 4; ++g) {
            const int n = nbase + 8 * g + 4 * h;
            u32x2 v = mk2(pack2(acc[mb][nb][4 * g], acc[mb][nb][4 * g + 1]), pack2(acc[mb][nb][4 * g + 2], acc[mb][nb][4 * g + 3]));
            *(u32x2*)(e.out + (size_t)m * e.out_ld + n) = v;
          }
        } else if (MODE == M_UKVK) {
#pragma unroll
          for (int g = 0; g < 4; ++g) {
            const int n = nbase + 8 * g + 4 * h;
            u32x2 v = mk2(pack2(acc[mb][nb][4 * g] * rsv, acc[mb][nb][4 * g + 1] * rsv), pack2(acc[mb][nb][4 * g + 2] * rsv, acc[mb][nb][4 * g + 3] * rsv));
            *(u32x2*)(e.out + (size_t)m * 384 + (n >> 6) * 96 + (n & 63)) = v;
          }
        } else if (MODE == M_UQ) {
          if (n0 < 256) {
#pragma unroll
            for (int g = 0; g < 4; ++g) {
              const int n = nbase + 8 * g + 4 * h;
              u32x2 v = mk2(pack2(acc[mb][nb][4 * g] * rsv, acc[mb][nb][4 * g + 1] * rsv), pack2(acc[mb][nb][4 * g + 2] * rsv, acc[mb][nb][4 * g + 3] * rsv));
              *(u32x2*)(e.out + (size_t)m * 384 + (n >> 6) * 96 + (n & 63)) = v;
            }
          } else {
            const int head = wn * 2 + nb;
#pragma unroll
            for (int g = 0; g < 2; ++g) {
              const int d = 8 * g + 4 * h;
              const f32x4 cs = rcs[g];
              const f32x4 sn = rsn[g];
              const float c_[4] = {cs.x, cs.y, cs.z, cs.w}, s_[4] = {sn.x, sn.y, sn.z, sn.w};
              float o1[4], o2[4];
#pragma unroll
              for (int j = 0; j < 4; ++j) {
                const float x1 = acc[mb][nb][4 * g + j] * rsv, x2 = acc[mb][nb][4 * (g + 2) + j] * rsv;
                o1[j] = x1 * c_[j] - x2 * s_[j];
                o2[j] = x2 * c_[j] + x1 * s_[j];
              }
              u16* dst = e.out + (size_t)m * 384 + head * 96 + 64 + d;
              *(u32x2*)dst = mk2(pack2(o1[0], o1[1]), pack2(o1[2], o1[3]));
              *(u32x2*)(dst + 16) = mk2(pack2(o2[0], o2[1]), pack2(o2[2], o2[3]));
            }
          }
        } else if (MODE == M_G3) {
        }
      }
    }
  } else {
    const int b = m0 / e.seq, s0 = m0 % e.seq;
#pragma unroll
    for (int nb = 0; nb < 2; ++nb) {
      const int n = n0 + wn * 64 + nb * 32 + r;
      u16* rowp = e.vt + ((size_t)b * e.hrows + (n - e.nseg0)) * e.seq + s0;
#pragma unroll
      for (int mb = 0; mb < 2; ++mb) {
#pragma unroll
        for (int g = 0; g < 4; ++g) {
          const int ml = wm * 64 + mb * 32 + 8 * g + 4 * h;
          float v0 = acc[mb][nb][4 * g], v1 = acc[mb][nb][4 * g + 1], v2 = acc[mb][nb][4 * g + 2], v3 = acc[mb][nb][4 * g + 3];
          if (MODE == M_UKVV) {
            const f32x4 rv = *(const f32x4*)(rs + ml);
            v0 *= rv.x; v1 *= rv.y; v2 *= rv.z; v3 *= rv.w;
          }
          *(u32x2*)(rowp + ml) = mk2(pack2(v0, v1), pack2(v2, v3));
        }
      }
    }
  }
}

template <int KT>
DI void mla_load_a(const u16* proj, int m0, int col0, char* smem, const int tid_in) {
  int tid = tid_in; asm volatile("" : "+v"(tid));
  const int lrow = tid >> 2, lch = (tid & 3) * 8;
  const u16* Ag = proj + (size_t)(m0 + lrow) * NP + col0 + lch;
  u32x4 ra[KT][2];
#pragma unroll
  for (int kt = 0; kt < KT; ++kt)
#pragma unroll
    for (int i = 0; i < 2; ++i) ra[kt][i] = *(const u32x4*)(Ag + (size_t)(128 * i) * NP + kt * 32);
  u16* Aw = (u16*)smem + lrow * GROW + lch;
#pragma unroll
  for (int kt = 0; kt < KT; ++kt)
#pragma unroll
    for (int i = 0; i < 2; ++i) *(u32x4*)(Aw + kt * (256 * GROW) + (128 * i) * GROW) = ra[kt][i];
}

template <int KDIM>
DI void compute_rs(const u16* proj, int m0, int col0, float* rs, const int tid_in) {
  int tid = tid_in; asm volatile("" : "+v"(tid));
  const u16* rowp = proj + (size_t)(m0 + tid) * NP + col0;
  u32x4 v[KDIM / 8];
#pragma unroll
  for (int c = 0; c < KDIM / 8; ++c) v[c] = *(const u32x4*)(rowp + c * 8);
  float ss = 0.f;
#pragma unroll
  for (int c = 0; c < KDIM / 8; ++c) {
    const unsigned w[4] = {v[c].x, v[c].y, v[c].z, v[c].w};
#pragma unroll
    for (int i = 0; i < 4; ++i) { const float a = lo_f(w[i]), b = hi_f(w[i]); ss += a * a + b * b; }
  }
  rs[tid] = rsqrtf(ss / (float)KDIM + 1e-6f);
}

struct AttnBlk {
  const u16* k; int k_ld;
  const u16* vt; int vt_ld;
  int kt_begin, kt_end;
  int c;
};
struct AttnWave {
  const u16* q; int q_ld;
  const u16* gate;
  u16* out;
  int hoff;
  int my_kt_end;
  float m_init; float l_init;
  const float* bias;
  int qi0;
};

#ifndef ATT_HINTS
#define ATT_HINTS 1
#endif
template <int DQK, int NH, int MODE, int PROBE = 0>
DI void attn_item(const AttnBlk& ab, const AttnWave& aw, char* smem, const int tid_in) {
  int tid = tid_in; asm volatile("" : "+v"(tid));
  constexpr int KCOLS = NH * DQK;
  constexpr int KROWB = (KCOLS + 8) * 2;
  constexpr int CPR = KCOLS / 8;
  constexpr int KTOT = 64 * CPR;
  constexpr int NKC = (KTOT + 511) / 512;
  constexpr int NVC = NH;
  constexpr int KIMG = 64 * KROWB;
  constexpr int STAGE = KIMG + NH * 64 * VROWB;
  constexpr int NKS = DQK / 16;
  constexpr bool DEEP = false;
  const int lane = tid & 63, r = lane & 31, h = lane >> 5;

  bf16x8 qf[NKS];
#pragma unroll
  for (int ks = 0; ks < NKS; ++ks) qf[ks] = *(const bf16x8*)(aw.q + (size_t)r * aw.q_ld + ks * 16 + 8 * h);

  f32x16 o0, o1;
#pragma unroll
  for (int i = 0; i < 16; ++i) { o0[i] = 0.f; o1[i] = 0.f; }
  float l = aw.l_init;
  f32x16 cinit;
#pragma unroll
  for (int i = 0; i < 16; ++i) cinit[i] = 0.f;
  constexpr bool CSHIFT = (NH != 4);
  float msub = 0.f;

  const int t0 = ab.kt_begin, te = ab.kt_end, nt = te - t0;
  const int my_n = aw.my_kt_end - t0;
  const gptr_t kb_ = uniform_ptr(ab.k); const gptr_t vb_ = uniform_ptr(ab.vt);
  const int kld_ = __builtin_amdgcn_readfirstlane(ab.k_ld), vld_ = __builtin_amdgcn_readfirstlane(ab.vt_ld);
  constexpr bool AFFINE = ((CPR & (CPR - 1)) == 0) && (KTOT % 512 == 0);
  unsigned koff[AFFINE ? 1 : NKC], voff[1];
  if constexpr (AFFINE) { koff[0] = (unsigned)((tid / CPR) * kld_ + (tid % CPR) * 8) * 2u; }
  else {
#pragma unroll
    for (int i = 0; i < NKC; ++i) { int id = tid + 512 * i; id = id < KTOT ? id : id - 512; const int row = id / CPR, cc = id % CPR; koff[i] = (unsigned)(row * kld_ + cc * 8) * 2u; }
  }
  voff[0] = (unsigned)((tid >> 3) * vld_ + (tid & 7) * 8) * 2u;
  const unsigned kstr_ = (unsigned)((512 / CPR) * kld_) * 2u, vstr_ = (unsigned)(64 * vld_) * 2u;
  u32x4 rk0[NKC], rv0[NVC], rk1[NKC], rv1[NVC];
#define A_LOADK(RK, j_) { const int t_ = (t0 + (j_) < te) ? t0 + (j_) : te - 1; const gptr_t kp_ = kb_ + (size_t)t_ * 128 * (size_t)kld_; \
    _Pragma("unroll") for (int i = 0; i < NKC; ++i) RK[i] = *(const __attribute__((address_space(1))) u32x4*)(kp_ + (AFFINE ? (size_t)i * kstr_ + koff[0] : (size_t)koff[AFFINE ? 0 : i])); }
#define A_LOADV(RV, j_) { const int t_ = (t0 + (j_) < te) ? t0 + (j_) : te - 1; const gptr_t vp_ = vb_ + (size_t)t_ * 128; \
    _Pragma("unroll") for (int i = 0; i < NVC; ++i) RV[i] = *(const __attribute__((address_space(1))) u32x4*)(vp_ + ((size_t)i * vstr_ + voff[0])); }
#define A_WRITEK(RK, st_) { char* Kw_ = smem + (st_) * STAGE; \
    _Pragma("unroll") for (int i = 0; i < NKC; ++i) { int id = tid + 512 * i; id = id < KTOT ? id : id - 512; const int row = id / CPR, cc = id % CPR; \
      *(u32x4*)(Kw_ + row * KROWB + cc * 16) = RK[i]; } }
#define A_WRITEV(RV, st_) { char* Vw_ = smem + (st_) * STAGE + KIMG; \
    _Pragma("unroll") for (int i = 0; i < NVC; ++i) { const int id = tid + 512 * i, row = id >> 3, cc = id & 7; \
      char* d_ = Vw_ + row * VROWB + (cc >> 1) * 32 + (cc & 1) * 8; \
      *(u32x2*)d_ = mk2(RV[i].x, RV[i].y); *(u32x2*)(d_ + 16) = mk2(RV[i].z, RV[i].w); } }

  const char* kl0 = smem + r * KROWB + (aw.hoff * DQK + 8 * h) * 2;
  const char* vl0 = smem + KIMG + (aw.hoff * 64 + r) * VROWB + h * 16;
  f32x16 sa0, sa1, sb0, sb1;

  auto kload = [&](const int st, bf16x8 (&kf)[2 * NKS]) {
    const char* kl = kl0 + st * STAGE;
#pragma unroll
    for (int ks = 0; ks < NKS; ++ks) { kf[2 * ks] = *(const bf16x8*)(kl + ks * 32); kf[2 * ks + 1] = *(const bf16x8*)(kl + 32 * KROWB + ks * 32); }
  };
  auto qk = [&](const bf16x8 (&kf)[2 * NKS], f32x16& a0, f32x16& a1) {
    a0 = MFMA(kf[0], qf[0], cinit);
    a1 = MFMA(kf[1], qf[0], cinit);
#pragma unroll
    for (int ks = 1; ks < NKS; ++ks) { a0 = MFMA(kf[2 * ks], qf[ks], a0); a1 = MFMA(kf[2 * ks + 1], qf[ks], a1); }
  };
  auto step = [&](const int stk, const int stv, const int kt, f32x16& s0, f32x16& s1, f32x16& n0, f32x16& n1) {
    bf16x8 kf[2 * NKS];
    kload(stk, kf);
    __builtin_amdgcn_sched_barrier(0);
    if (MODE == 1) {
      const int dc = ab.c - kt;
      if (dc >= 3) {
        const float bv = aw.bias[256];
#pragma unroll
        for (int i = 0; i < 16; ++i) { s0[i] += bv; s1[i] += bv; }
      } else {
        const int base = 64 * dc + aw.qi0 + r + 128;
#pragma unroll
        for (int i = 0; i < 16; ++i) {
          const int ki = (i & 3) + 8 * (i >> 2) + 4 * h;
          int i0 = base - ki; i0 = i0 > 256 ? 256 : i0;
          int i1 = base - 32 - ki; i1 = i1 > 256 ? 256 : i1;
          s0[i] += aw.bias[i0];
          s1[i] += aw.bias[i1];
        }
      }
    }
    const char* vl = vl0 + stv * STAGE;
    u32x4 vr[4][2];
#define V_READ(b_) { _Pragma("unroll") for (int db = 0; db < 2; ++db) vr[b_][db] = *(const u32x4*)(vl + (b_) * 32 + db * 32 * VROWB); }
    V_READ(0);
    __builtin_amdgcn_sched_barrier(0);
    qk(kf, n0, n1);
    f32x2_t ps2 = {0.f, 0.f};
#pragma unroll
    for (int i = 0; i < 16; i += 2) {
      if constexpr (CSHIFT) {
        s0[i] = fast_exp2(s0[i]); s0[i + 1] = fast_exp2(s0[i + 1]);
        s1[i] = fast_exp2(s1[i]); s1[i + 1] = fast_exp2(s1[i + 1]);
      } else {
        s0[i] = fast_exp2(s0[i] - msub); s0[i + 1] = fast_exp2(s0[i + 1] - msub);
        s1[i] = fast_exp2(s1[i] - msub); s1[i + 1] = fast_exp2(s1[i + 1] - msub);
      }
      f32x2_t a = {s0[i], s0[i + 1]}, b = {s1[i], s1[i + 1]};
      ps2 += a; ps2 += b;
    }
    l += ps2.x + ps2.y;
#pragma unroll
    for (int kb = 0; kb < 2; ++kb) {
#pragma unroll
      for (int s2 = 0; s2 < 2; ++s2) {
        const int bq = kb * 2 + s2;
        if (bq == 0) { V_READ(1); } else if (bq == 1) { V_READ(2); } else if (bq == 2) { V_READ(3); }
        u32x4 pw;
        if (kb == 0) pw = mk4(pack2(s0[8 * s2], s0[8 * s2 + 1]), pack2(s0[8 * s2 + 2], s0[8 * s2 + 3]), pack2(s0[8 * s2 + 4], s0[8 * s2 + 5]), pack2(s0[8 * s2 + 6], s0[8 * s2 + 7]));
        else pw = mk4(pack2(s1[8 * s2], s1[8 * s2 + 1]), pack2(s1[8 * s2 + 2], s1[8 * s2 + 3]), pack2(s1[8 * s2 + 4], s1[8 * s2 + 5]), pack2(s1[8 * s2 + 6], s1[8 * s2 + 7]));
        const bf16x8 pf = __builtin_bit_cast(bf16x8, pw);
        {
          const bf16x8 vf = __builtin_bit_cast(bf16x8, vr[bq][0]);
          o0 = MFMA(vf, pf, o0);
        }
        {
          const bf16x8 vf = __builtin_bit_cast(bf16x8, vr[bq][1]);
          o1 = MFMA(vf, pf, o1);
        }
      }
    }
#undef V_READ
  };

  constexpr bool PAIR = (NH == 1 && DQK == 96);
  if constexpr (PAIR) {
    A_LOADK(rk0, 0); A_LOADV(rv0, 0); A_LOADK(rk1, 1); A_LOADV(rv1, 1);
    A_WRITEK(rk0, 0); A_WRITEV(rv0, 0); A_WRITEK(rk1, 1); A_WRITEV(rv1, 1);
    A_LOADK(rk0, 2);
    A_WRITEK(rk0, 2);
    A_LOADK(rk0, 3); A_LOADK(rk1, 4); A_LOADV(rv0, 2); A_LOADV(rv1, 3);
  } else if constexpr (DEEP) {
    A_LOADK(rk0, 0); A_LOADV(rv0, 0); A_LOADK(rk1, 1);
    A_WRITEK(rk0, 0); A_WRITEV(rv0, 0); A_WRITEK(rk1, 1);
    A_LOADK(rk0, 2); A_LOADV(rv1, 1); A_LOADK(rk1, 3); A_LOADV(rv0, 2);
  } else {
    A_LOADK(rk0, 0); A_LOADV(rv0, 0); A_LOADK(rk1, 1);
    A_WRITEK(rk0, 0); A_WRITEV(rv0, 0); A_WRITEK(rk1, 1);
    A_LOADK(rk0, 2); A_LOADV(rv0, 1);
  }
  __syncthreads();
  if (PROBE != 1) {
    bf16x8 kf0[2 * NKS]; kload(0, kf0); qk(kf0, sa0, sa1);
    float mx = sa0[0];
#pragma unroll
    for (int i = 1; i < 16; ++i) mx = fmaxf(mx, sa0[i]);
#pragma unroll
    for (int i = 0; i < 16; ++i) mx = fmaxf(mx, sa1[i]);
    mx = fmaxf(mx, __shfl_xor(mx, 32));
    const float m0 = (MODE == 2) ? fmaxf(mx, aw.m_init) : mx;
    if (MODE == 2) l = ((lane < 32) ? 1.0f : 0.0f) * fast_exp2(aw.m_init - m0);
    if constexpr (CSHIFT) {
#pragma unroll
      for (int i = 0; i < 16; ++i) cinit[i] = -m0;
      qk(kf0, sa0, sa1);
    } else { msub = m0; }
  }
  __syncthreads();
  if constexpr (PAIR) {
    for (int j = 0; j < nt; j += 4) {
      A_WRITEK(rk0, 3); A_WRITEK(rk1, 0); A_WRITEV(rv0, 2); A_WRITEV(rv1, 3);
      A_LOADK(rk0, j + 5); A_LOADK(rk1, j + 6); A_LOADV(rv0, j + 4); A_LOADV(rv1, j + 5);
      if (PROBE != 1 && j < my_n) step(1, 0, t0 + j, sa0, sa1, sb0, sb1);
      if (PROBE != 1 && j + 1 < my_n) step(2, 1, t0 + j + 1, sb0, sb1, sa0, sa1);
      __syncthreads();
      if (j + 2 >= nt) break;
      A_WRITEK(rk0, 1); A_WRITEK(rk1, 2); A_WRITEV(rv0, 0); A_WRITEV(rv1, 1);
      A_LOADK(rk0, j + 7); A_LOADK(rk1, j + 8); A_LOADV(rv0, j + 6); A_LOADV(rv1, j + 7);
      if (PROBE != 1 && j + 2 < my_n) step(3, 2, t0 + j + 2, sa0, sa1, sb0, sb1);
      if (PROBE != 1 && j + 3 < my_n) step(0, 3, t0 + j + 3, sb0, sb1, sa0, sa1);
      __syncthreads();
    }
  } else
  for (int j = 0; j < nt; j += 2) {
    if constexpr (DEEP) { A_WRITEK(rk0, 0); A_WRITEV(rv1, 1); A_LOADK(rk0, j + 4); A_LOADV(rv1, j + 3); }
    else { A_WRITEK(rk0, 0); A_WRITEV(rv0, 1); A_LOADK(rk0, j + 3); A_LOADV(rv0, j + 2); }
    if (PROBE != 1 && j < my_n) step(1, 0, t0 + j, sa0, sa1, sb0, sb1);
    __syncthreads();
    if (j + 1 >= nt) break;
    if constexpr (DEEP) { A_WRITEK(rk1, 1); A_WRITEV(rv0, 0); A_LOADK(rk1, j + 5); A_LOADV(rv0, j + 4); }
    else { A_WRITEK(rk0, 1); A_WRITEV(rv0, 0); A_LOADK(rk0, j + 4); A_LOADV(rv0, j + 3); }
    if (PROBE != 1 && j + 1 < my_n) step(0, 1, t0 + j + 1, sb0, sb1, sa0, sa1);
    __syncthreads();
  }
#undef A_LOADK
#undef A_LOADV
#undef A_WRITEK
#undef A_WRITEV
  const float lt = l + __shfl_xor(l, 32);
  const float inv = 1.0f / lt;
  u32x2 gv[2][4];
#pragma unroll
  for (int db = 0; db < 2; ++db)
#pragma unroll
    for (int g = 0; g < 4; ++g) gv[db][g] = *(const u32x2*)(aw.gate + (size_t)r * NP + db * 32 + 8 * g + 4 * h);
#pragma unroll
  for (int db = 0; db < 2; ++db) {
#pragma unroll
    for (int g = 0; g < 4; ++g) {
      const int d0 = db * 32 + 8 * g + 4 * h;
      float v[4];
#pragma unroll
      for (int j = 0; j < 4; ++j) v[j] = (db == 0 ? o0[4 * g + j] : o1[4 * g + j]) * inv;
      v[0] *= silu_f(lo_f(gv[db][g].x)); v[1] *= silu_f(hi_f(gv[db][g].x));
      v[2] *= silu_f(lo_f(gv[db][g].y)); v[3] *= silu_f(hi_f(gv[db][g].y));
      if (PROBE == 0) *(u32x2*)(aw.out + (size_t)r * DM + d0) = mk2(pack2(v[0], v[1]), pack2(v[2], v[3]));
      else if (v[0] == 123.456f) *(u32x2*)(aw.out + (size_t)r * DM + d0) = mk2(pack2(v[0], v[1]), pack2(v[2], v[3]));
    }
  }
}

struct WorkQ { unsigned* ctr; int x; int dx; int per; int* slot; };
DI WorkQ wq_init(const Params& p, int l, int phase, int x, int per, char* smem) {
  WorkQ w; w.ctr = (unsigned*)(p.ws + OFF_WQ) + ((size_t)(l * 4 + phase) * 8) * 16; w.x = x & 0x107; w.dx = 0; w.per = per;
  w.slot = (int*)(smem + SM_ITEM);
  return w;
}
DI int wq_next(WorkQ& w, int& q) {
  for (;;) {
    if (w.dx >= 8) return -1;
    q = (w.x + w.dx) & 7;
    __syncthreads();
    if (threadIdx.x == 0) *w.slot = (int)__hip_atomic_fetch_add(&w.ctr[q * 16], 1u, __ATOMIC_RELAXED, __HIP_MEMORY_SCOPE_AGENT);
    __syncthreads();
    const int t = __builtin_amdgcn_readfirstlane(*w.slot);
    if (t < w.per) return t;
    w.dx += (w.x & 0x100) ? 8 : 1;
  }
}

DI void phase_gemm(const Params& p, int l, int which, int cperm, pg8::PG8_LAS_T lds) {
  char* ws = p.ws;
  pg8::Gemm g; pg8::EpiBf16 E;
  if (which == 0) { g.A = (const u16*)(ws + OFF_XB); g.Bt = (const u16*)(ws + OFF_WIN) + (size_t)l * NP * DM; g.M = T_TOK; g.N = NP; E.O = (u16*)(ws + OFF_PROJ); }
  else if (which == 1) { g.A = (const u16*)(ws + OFF_MEMB); g.Bt = (const u16*)(ws + OFF_WMKV); g.M = 4096; g.N = 2048; E.O = (u16*)(ws + OFF_KVMEM); }
  else { g.A = (const u16*)(ws + OFF_GATED); g.Bt = (const u16*)(ws + OFF_WOUT) + (size_t)l * DM * DM; g.M = T_TOK; g.N = DM; E.O = (u16*)(ws + OFF_PROJ); }
  g.K = DM; E.ldc = g.N; E.nt = (which == 0) ? 1 : 0;
  pg8::StaticOrder S; S.init(g.M, g.N, (int)gridDim.x, cperm);
  pg8::gemm_phase<pg8::EpiBf16, pg8::StaticOrder, false>(lds, g, S, E, nullptr);
}

template <int NHD, class SrcF, class DstF>
DI void vt_strip(SrcF src_of, int src_ld, DstF dst_of, int dst_ld, u16* T, int tid_in) {
  int tid = tid_in; asm volatile("" : "+v"(tid));
  const int rr = tid >> 3, ch = tid & 7;
  u32x4 v[NHD];
#pragma unroll
  for (int hd = 0; hd < NHD; ++hd) v[hd] = __builtin_nontemporal_load((const u32x4*)(src_of(hd) + (size_t)rr * src_ld + ch * 8));
#pragma unroll
  for (int hd = 0; hd < NHD; ++hd) {
    u16* Th = T + hd * (64 * 72);
    const unsigned w[4] = {v[hd].x, v[hd].y, v[hd].z, v[hd].w};
#pragma unroll
    for (int j = 0; j < 4; ++j) {
      Th[(ch * 8 + 2 * j) * 72 + ((rr + 8 * ch) & 63)] = (u16)(w[j] & 0xffffu);
      Th[(ch * 8 + 2 * j + 1) * 72 + ((rr + 8 * ch) & 63)] = (u16)(w[j] >> 16);
    }
  }
  __syncthreads();
#pragma unroll
  for (int hd = 0; hd < NHD; ++hd)
    *(u32x4*)(dst_of(hd) + (size_t)rr * dst_ld + ch * 8) = *(const u32x4*)(T + hd * (64 * 72) + rr * 72 + ((ch + (rr >> 3)) & 7) * 8);
  __syncthreads();
}

DI void phase_b1(const Params& p, int l, int xcd, char* smem) {
  char* ws = p.ws;
  u16* proj = (u16*)(ws + OFF_PROJ);
  const int tid = opaque_tid();
  {
    float* rs = (float*)(smem + SM_RS);
    WorkQ w = wq_init(p, l, 1, xcd, 64, smem);
    for (;;) {
      int q; const int u2 = wq_next(w, q);
      if (u2 < 0) break;
      const int grp = u2 >> 5, mt = 32 * q + (u2 & 31);
      const int m0 = mt * 256;
      Epi e{};
      if (grp == 0) {
        mla_load_a<6>(proj, m0, C_BCQ, smem, tid);
        if (tid < 256) compute_rs<192>(proj, m0, C_BCQ, rs, tid);
        __syncthreads();
        e.out = (u16*)(ws + OFF_QB); e.c32 = (const float*)(ws + OFF_COS32); e.s32 = (const float*)(ws + OFF_SIN32);
        for (int j = 0; j < 3; ++j)
          mla_tile8<M_UQ, 6>((const u16*)(ws + OFF_WUQ) + (size_t)l * 384 * 192, 192, m0, j * 128, e, smem, rs, tid);
      } else {
        mla_load_a<4>(proj, m0, C_BCKV, smem, tid);
        if (tid < 256) compute_rs<128>(proj, m0, C_BCKV, rs, tid);
        __syncthreads();
        const u16* wk = (const u16*)(ws + OFF_WUKV) + (size_t)l * 512 * 128;
        e.out = (u16*)(ws + OFF_KB);
        for (int nt = 0; nt < 2; ++nt)
          mla_tile8<M_UKVK, 4>(wk, 128, m0, nt * 128, e, smem, rs, tid);
        e.vt = (u16*)(ws + OFF_VTB); e.seq = SEQ; e.nseg0 = 256; e.hrows = 256;
        for (int nt = 2; nt < 4; ++nt)
          mla_tile8<M_UKVV, 4>(wk, 128, m0, nt * 128, e, smem, rs, tid);
      }
    }
  }
  __syncthreads();
  {
    u16* T = (u16*)smem;
    for (int tt = blockIdx.x; tt < 1024; tt += gridDim.x) {
      const int b = tt >> 6, s0 = (tt & 63) * 64;
      const u16* srow = proj + (size_t)tt * 64 * NP;
      u16* vta = (u16*)(ws + OFF_VTA) + ((size_t)(b * 4) * 64) * SEQ + s0;
      u16* vtc = (u16*)(ws + OFF_VTC) + ((size_t)(b * 2) * 64) * SEQ + s0;
      vt_strip<6>([&](int hd) { return srow + (hd < 4 ? C_AV + hd * 64 : C_CV + (hd - 4) * 64); }, NP,
                  [&](int hd) { return hd < 4 ? vta + (size_t)hd * 64 * SEQ : vtc + (size_t)(hd - 4) * 64 * SEQ; }, SEQ, T, tid);
    }
    if (l == 0) {
      for (int v = blockIdx.x; v < 256; v += gridDim.x) {
        const int ll = v >> 6, tt = v & 63;
        const int b = tt >> 2, s0 = (tt & 3) * 64;
        const u16* srow = (const u16*)(ws + OFF_KVMEM) + (size_t)tt * 64 * 2048 + ll * 512 + 256;
        u16* vtm = (u16*)(ws + OFF_VTMEM) + ((size_t)ll * 4096 + (size_t)(b * 4) * 64) * 256 + s0;
        vt_strip<4>([&](int hd) { return srow + hd * 64; }, 2048,
                    [&](int hd) { return vtm + (size_t)hd * 64 * 256; }, 256, T, tid);
      }
    }
  }
  const size_t gtid = (size_t)blockIdx.x * NTHR + tid;
  const size_t gn = (size_t)gridDim.x * NTHR;
  const float* c64 = (const float*)(ws + OFF_COS64); const float* s64 = (const float*)(ws + OFF_SIN64);
  const float* c32 = (const float*)(ws + OFF_COS32); const float* s32 = (const float*)(ws + OFF_SIN32);
  for (size_t i = gtid; i < (size_t)T_TOK * 24; i += gn) {
    const int tok = (int)(i / 24), u = (int)(i % 24);
    const int slot = u >> 2, c = u & 3;
    const int col0 = (slot < 4) ? (C_CQ + slot * 64) : (C_CK + (slot - 4) * 64);
    u16* p1 = proj + (size_t)tok * NP + col0 + 8 * c;
    const u32x4 a = *(const u32x4*)p1, b = *(const u32x4*)(p1 + 32);
    const f32x4 ca = *(const f32x4*)(c64 + (size_t)tok * 32 + 8 * c), cb = *(const f32x4*)(c64 + (size_t)tok * 32 + 8 * c + 4);
    const f32x4 sa = *(const f32x4*)(s64 + (size_t)tok * 32 + 8 * c), sb = *(const f32x4*)(s64 + (size_t)tok * 32 + 8 * c + 4);
    const float cs[8] = {ca.x, ca.y, ca.z, ca.w, cb.x, cb.y, cb.z, cb.w};
    const float sn[8] = {sa.x, sa.y, sa.z, sa.w, sb.x, sb.y, sb.z, sb.w};
    const unsigned aw_[4] = {a.x, a.y, a.z, a.w}, bw_[4] = {b.x, b.y, b.z, b.w};
    unsigned o1[4], o2[4];
#pragma unroll
    for (int j = 0; j < 4; ++j) {
      const float x1a = lo_f(aw_[j]), x1b = hi_f(aw_[j]), x2a = lo_f(bw_[j]), x2b = hi_f(bw_[j]);
      o1[j] = pack2(x1a * cs[2 * j] - x2a * sn[2 * j], x1b * cs[2 * j + 1] - x2b * sn[2 * j + 1]);
      o2[j] = pack2(x2a * cs[2 * j] + x1a * sn[2 * j], x2b * cs[2 * j + 1] + x1b * sn[2 * j + 1]);
    }
    *(u32x4*)p1 = mk4(o1[0], o1[1], o1[2], o1[3]);
    *(u32x4*)(p1 + 32) = mk4(o2[0], o2[1], o2[2], o2[3]);
  }
  u16* kB = (u16*)(ws + OFF_KB);
  for (size_t i = gtid; i < (size_t)T_TOK * 2; i += gn) {
    const int tok = (int)(i >> 1), c = (int)(i & 1);
    const u16* p1 = proj + (size_t)tok * NP + C_BKR + 8 * c;
    const u32x4 a = *(const u32x4*)p1, b = *(const u32x4*)(p1 + 16);
    const f32x4 ca = *(const f32x4*)(c32 + (size_t)tok * 16 + 8 * c), cb = *(const f32x4*)(c32 + (size_t)tok * 16 + 8 * c + 4);
    const f32x4 sa = *(const f32x4*)(s32 + (size_t)tok * 16 + 8 * c), sb = *(const f32x4*)(s32 + (size_t)tok * 16 + 8 * c + 4);
    const float cs[8] = {ca.x, ca.y, ca.z, ca.w, cb.x, cb.y, cb.z, cb.w};
    const float sn[8] = {sa.x, sa.y, sa.z, sa.w, sb.x, sb.y, sb.z, sb.w};
    const unsigned aw_[4] = {a.x, a.y, a.z, a.w}, bw_[4] = {b.x, b.y, b.z, b.w};
    unsigned o1[4], o2[4];
#pragma unroll
    for (int j = 0; j < 4; ++j) {
      const float x1a = lo_f(aw_[j]), x1b = hi_f(aw_[j]), x2a = lo_f(bw_[j]), x2b = hi_f(bw_[j]);
      o1[j] = pack2(x1a * cs[2 * j] - x2a * sn[2 * j], x1b * cs[2 * j + 1] - x2b * sn[2 * j + 1]);
      o2[j] = pack2(x2a * cs[2 * j] + x1a * sn[2 * j], x2b * cs[2 * j + 1] + x1b * sn[2 * j + 1]);
    }
#pragma unroll
    for (int hh = 0; hh < 4; ++hh) {
      u16* d = kB + (size_t)tok * 384 + hh * 96 + 64 + 8 * c;
      *(u32x4*)d = mk4(o1[0], o1[1], o1[2], o1[3]);
      *(u32x4*)(d + 16) = mk4(o2[0], o2[1], o2[2], o2[3]);
    }
  }
}

DI void phase_att(const Params& p, int l, int xcd, char* smem) {
  char* ws = p.ws;
  const int tid = opaque_tid();
  const int wave = __builtin_amdgcn_readfirstlane(tid >> 6);
  const u16* proj = (const u16*)(ws + OFF_PROJ);
  u16* gated = (u16*)(ws + OFF_GATED);
  float* biasl = (float*)(smem + SM_BIAS);
  for (int i = tid; i < 4 * 257; i += NTHR) biasl[i] = p.rel_bias[(size_t)l * 4 * 257 + i] * LOG2E;
  __syncthreads();
  WorkQ w = wq_init(p, l, 2, xcd, 512, smem);
  for (;;) {
    int q; const int u = wq_next(w, q);
    if (u < 0) break;
    AttnBlk ab{}; AttnWave aw{};
    aw.m_init = -1e30f; aw.l_init = 0.f;
    if (u < 128) {
      const int i2 = 15 - (u >> 3), pr = 8 * q + (u & 7), b = pr >> 2, hh = pr & 3;
      const int qb = 2 * i2 + (wave >> 2);
      const size_t tok0 = (size_t)b * SEQ + qb * 128 + (wave & 3) * 32;
      ab.k = (const u16*)(ws + OFF_KB) + (size_t)b * SEQ * 384 + hh * 96; ab.k_ld = 384;
      ab.vt = (const u16*)(ws + OFF_VTB) + ((size_t)b * 256 + hh * 64) * SEQ; ab.vt_ld = SEQ;
      ab.kt_begin = 0; ab.kt_end = 4 * i2 + 4; ab.c = 0;
      aw.q = (const u16*)(ws + OFF_QB) + tok0 * 384 + hh * 96; aw.q_ld = 384;
      aw.gate = proj + tok0 * NP + C_BG + hh * 64;
      aw.out = gated + tok0 * DM + 256 + hh * 64;
      aw.hoff = 0; aw.my_kt_end = 2 * qb + 1 + ((wave >> 1) & 1);
      attn_item<96, 1, 0>(ab, aw, smem, tid);
    } else if (u < 256) {
      const int it = u - 128;
      const int c = 63 - (it >> 1), b = 2 * q + (it & 1);
      const int head = wave >> 1;
      const size_t tok0 = (size_t)b * SEQ + c * 64 + (wave & 1) * 32;
      ab.k = proj + (size_t)b * SEQ * NP + C_AK; ab.k_ld = NP;
      ab.vt = (const u16*)(ws + OFF_VTA) + ((size_t)b * 256) * SEQ; ab.vt_ld = SEQ;
      ab.kt_begin = c - 8 < 0 ? 0 : c - 8; ab.kt_end = c + 1; ab.c = c;
      aw.q = proj + tok0 * NP + C_AQ + head * 64; aw.q_ld = NP;
      aw.gate = proj + tok0 * NP + C_AG + head * 64;
      aw.out = gated + tok0 * DM + head * 64;
      aw.hoff = head; aw.my_kt_end = c + 1;
      aw.bias = biasl + head * 257; aw.qi0 = (wave & 1) * 32;
      attn_item<64, 4, 1>(ab, aw, smem, tid);
    } else if (u < 384) {
      const int it = u - 256;
      const int c = it >> 1, b = 2 * q + (it & 1);
      const int head = wave >> 1;
      const size_t tok0 = (size_t)b * SEQ + c * 64 + (wave & 1) * 32;
      ab.k = (const u16*)(ws + OFF_KVMEM) + (size_t)(b * 256) * 2048 + l * 512; ab.k_ld = 2048;
      ab.vt = (const u16*)(ws + OFF_VTMEM) + ((size_t)l * 4096 + b * 256) * 256; ab.vt_ld = 256;
      ab.kt_begin = 0; ab.kt_end = 4; ab.c = 0;
      aw.q = proj + tok0 * NP + C_MQ + head * 64; aw.q_ld = NP;
      aw.gate = proj + tok0 * NP + C_MG + head * 64;
      aw.out = gated + tok0 * DM + 768 + head * 64;
      aw.hoff = head; aw.my_kt_end = 4;
      attn_item<64, 4, 0>(ab, aw, smem, tid);
    } else {
      const int it = u - 384;
      const int c = it >> 1, b = 2 * q + (it & 1);
      const int kvh = wave >> 2, head = 2 * kvh + ((wave >> 1) & 1);
      const size_t tok0 = (size_t)b * SEQ + c * 64 + (wave & 1) * 32;
      ab.k = proj + (size_t)b * SEQ * NP + C_CK; ab.k_ld = NP;
      ab.vt = (const u16*)(ws + OFF_VTC) + ((size_t)b * 128) * SEQ; ab.vt_ld = SEQ;
      ab.kt_begin = c - 2 < 0 ? 0 : c - 2; ab.kt_end = c + 1; ab.c = c;
      aw.q = proj + tok0 * NP + C_CQ + head * 64; aw.q_ld = NP;
      aw.gate = proj + tok0 * NP + C_CG + head * 64;
      aw.out = gated + tok0 * DM + 512 + head * 64;
      aw.hoff = kvh; aw.my_kt_end = c + 1;
      aw.m_init = p.sinks[l * 4 + head] * LOG2E;
      attn_item<64, 2, 2>(ab, aw, smem, tid);
    }
  }
}

DI void phase_ln(const Params& p, int l) {
  char* ws = p.ws;
  u16* xb = (u16*)(ws + OFF_XB);
  const int tid = opaque_tid();
  const int lane = tid & 63;
  const int gw = blockIdx.x * 8 + (tid >> 6), nw = gridDim.x * 8;
  const float* g = p.ln_g + l * DM; const float* bb = p.ln_b + l * DM;
  const float* xin = (l == 0) ? p.x : p.out;
  const u16* yb = (const u16*)(ws + OFF_PROJ);
  const float alpha = 1.681792830507429f;
  f32x4 gv[4], bv[4];
#pragma unroll
  for (int i = 0; i < 4; ++i) { gv[i] = *(const f32x4*)(g + i * 256 + lane * 4); bv[i] = *(const f32x4*)(bb + i * 256 + lane * 4); }
  for (int row0 = gw * 4; row0 < T_TOK; row0 += nw * 4) {
    f32x4 v[4][4]; u32x2 yv[4][4];
#pragma unroll
    for (int rr = 0; rr < 4; ++rr)
#pragma unroll
      for (int i = 0; i < 4; ++i) {
        v[rr][i] = __builtin_nontemporal_load((const f32x4*)(xin + (size_t)(row0 + rr) * DM + i * 256 + lane * 4));
        yv[rr][i] = __builtin_nontemporal_load((const u32x2*)(yb + (size_t)(row0 + rr) * DM + i * 256 + lane * 4));
      }
#pragma unroll
    for (int rr = 0; rr < 4; ++rr)
#pragma unroll
      for (int i = 0; i < 4; ++i) {
        v[rr][i].x = alpha * v[rr][i].x + lo_f(yv[rr][i].x); v[rr][i].y = alpha * v[rr][i].y + hi_f(yv[rr][i].x);
        v[rr][i].z = alpha * v[rr][i].z + lo_f(yv[rr][i].y); v[rr][i].w = alpha * v[rr][i].w + hi_f(yv[rr][i].y);
      }
#pragma unroll
    for (int rr = 0; rr < 4; ++rr) {
      float* rp = p.out + (size_t)(row0 + rr) * DM;
      float s = 0.f;
#pragma unroll
      for (int i = 0; i < 4; ++i) s += v[rr][i].x + v[rr][i].y + v[rr][i].z + v[rr][i].w;
#pragma unroll
      for (int o = 32; o >= 1; o >>= 1) s += __shfl_xor(s, o);
      const float mu = s * (1.0f / 1024.0f);
      float q = 0.f;
#pragma unroll
      for (int i = 0; i < 4; ++i) {
        v[rr][i].x -= mu; v[rr][i].y -= mu; v[rr][i].z -= mu; v[rr][i].w -= mu;
        q += v[rr][i].x * v[rr][i].x + v[rr][i].y * v[rr][i].y + v[rr][i].z * v[rr][i].z + v[rr][i].w * v[rr][i].w;
      }
#pragma unroll
      for (int o = 32; o >= 1; o >>= 1) q += __shfl_xor(q, o);
      const float rstd = rsqrtf(q * (1.0f / 1024.0f) + 1e-5f);
#pragma unroll
      for (int i = 0; i < 4; ++i) {
        f32x4 y;
        y.x = v[rr][i].x * rstd * gv[i].x + bv[i].x;
        y.y = v[rr][i].y * rstd * gv[i].y + bv[i].y;
        y.z = v[rr][i].z * rstd * gv[i].z + bv[i].z;
        y.w = v[rr][i].w * rstd * gv[i].w + bv[i].w;
        __builtin_nontemporal_store(y, (f32x4*)(rp + i * 256 + lane * 4));
        if (l + 1 < DEPTH) *(u32x2*)(xb + (size_t)(row0 + rr) * DM + i * 256 + lane * 4) = mk2(pack2(y.x, y.y), pack2(y.z, y.w));
      }
    }
  }
}

#define XB_TMO      128
#define XB_XCNT(j)  (256  + 64 * (j))
#define XB_XSUB(j)  (1280 + 64 * (j))
#define XB_XGEN(j)  (2304 + 64 * (j))
#define XB_TOP      3328
#define XB_TOPGEN   3392
#define XB_SPIN_CAP (1u << 22)
#define LAS __attribute__((address_space(3)))
DI unsigned xb_ld(unsigned* p) { return __hip_atomic_load(p, __ATOMIC_RELAXED, __HIP_MEMORY_SCOPE_AGENT); }
DI unsigned xb_add(unsigned* p, unsigned v) { return __hip_atomic_fetch_add(p, v, __ATOMIC_RELAXED, __HIP_MEMORY_SCOPE_AGENT); }
DI unsigned xb_xcc_id() { return (unsigned)__builtin_amdgcn_s_getreg((3 << 11) | 20) & 0xFu; }
#define XB_SPIN(cond, bar) do { unsigned _sp = 0; while (cond) { __builtin_amdgcn_s_sleep(1); \
    if ((++_sp & 255u) == 0u) { if (xb_ld(&(bar)[XB_TMO])) break; if (_sp > XB_SPIN_CAP) { atomicAdd(&(bar)[XB_TMO], 1u); break; } } } } while (0)
struct XcdBarrier { unsigned* bar; unsigned x; volatile LAS unsigned* st; unsigned rank; };
DI XcdBarrier xcd_barrier_post(unsigned* bar, volatile LAS unsigned* st) {
  XcdBarrier b; b.bar = bar; b.x = xb_xcc_id(); b.st = st;
  b.rank = 0u;
  if (threadIdx.x == 0) b.rank = xb_add(&bar[XB_XCNT(b.x)], 1u);
  return b;
}
DI void xcd_barrier_complete(unsigned* bar, unsigned x, unsigned& nloc, unsigned& nx) {
  const unsigned G = gridDim.x * gridDim.y * gridDim.z;
  unsigned sum, cnt, mine, sp = 0u;
  for (;;) {
    sum = 0u; cnt = 0u; mine = 0u;
#pragma unroll
    for (unsigned j = 0; j < 16; ++j) { const unsigned c = xb_ld(&bar[XB_XCNT(j)]); sum += c; cnt += (c > 0u) ? 1u : 0u; mine = (j == x) ? c : mine; }
    if (sum == G) break;
    __builtin_amdgcn_s_sleep(1);
    if ((++sp & 255u) == 0u) { if (xb_ld(&bar[XB_TMO])) break; if (sp > XB_SPIN_CAP) { atomicAdd(&bar[XB_TMO], 1u); break; } }
  }
  nloc = mine > 0u ? mine : 1u; nx = cnt > 0u ? cnt : 1u;
}
DI void xcd_barrier(const XcdBarrier& b) {
  asm volatile("s_waitcnt vmcnt(0)" ::: "memory");
  __syncthreads();
  if (threadIdx.x == 0) {
    unsigned* bar = b.bar;
    __builtin_amdgcn_s_waitcnt(0);
    unsigned nloc = b.st[0], nx = b.st[1];
    if (nloc == 0u) { xcd_barrier_complete(bar, b.x, nloc, nx); b.st[0] = nloc; b.st[1] = nx; }
    const unsigned old = xb_add(&bar[XB_XSUB(b.x)], 1u);
    const unsigned gen = old / nloc;
    if (old + 1u == (gen + 1u) * nloc) {
      __builtin_amdgcn_fence(__ATOMIC_RELEASE, "agent");
      asm volatile("s_waitcnt vmcnt(0)" ::: "memory");
      const unsigned og = xb_add(&bar[XB_TOP], 1u);
      const unsigned tg = og / nx;
      if (og + 1u == (tg + 1u) * nx) xb_add(&bar[XB_TOPGEN], 1u);
      else XB_SPIN(xb_ld(&bar[XB_TOPGEN]) == tg, bar);
      __builtin_amdgcn_fence(__ATOMIC_ACQUIRE, "agent");
      xb_add(&bar[XB_XGEN(b.x)], 1u);
      asm volatile("s_waitcnt vmcnt(0)" ::: "memory");
    } else {
      XB_SPIN(xb_ld(&bar[XB_XGEN(b.x)]) == gen, bar);
      __builtin_amdgcn_fence(__ATOMIC_ACQUIRE, "agent");
      asm volatile("s_waitcnt vmcnt(0)" ::: "memory");
    }
  }
  __syncthreads();
}

__global__ void __launch_bounds__(NTHR, 2) fwd_megakernel(Params p) {
  cg::grid_group grid = cg::this_grid();
  extern __shared__ __attribute__((aligned(16))) unsigned char shm[];
  char* smem = (char*)shm;
  pg8::PG8_LAS_T lds = (pg8::PG8_LAS_T)shm;
  if (threadIdx.x < 8) ((unsigned*)(smem + SM_XB))[threadIdx.x] = 0u;
  __syncthreads();
  XcdBarrier xb = xcd_barrier_post((unsigned*)(p.ws + OFF_BAR), (volatile LAS unsigned*)(smem + SM_XB));
  phase0(p, smem);
  grid.sync();
  int cperm, xcd_arg;
  {
    unsigned* bar = (unsigned*)(p.ws + OFF_BAR);
    if (threadIdx.x == 0) {
      const unsigned G = gridDim.x; bool uni = (G % 8u) == 0u; unsigned sum = 0u;
      for (unsigned j = 0; j < 16; ++j) { const unsigned c = xb_ld(&bar[XB_XCNT(j)]); sum += c; if (j < 8 ? (c != G / 8u) : (c != 0u)) uni = false; }
      if (sum != G) uni = false;
      *(int*)(smem + SM_ITEM) = uni ? (int)(0x10000u | (xb.x + 8u * xb.rank)) : (int)blockIdx.x;
    }
    __syncthreads();
    const int packed = __builtin_amdgcn_readfirstlane(*(int*)(smem + SM_ITEM));
    cperm = packed & 0xffff;
    xcd_arg = (int)xb.x | ((packed >> 16) ? 0x100 : 0);
    __syncthreads();
  }
  for (int ph = 0; ph < DEPTH * 5; ++ph) {
    const int l = ph / 5, k = ph % 5;
    if (k == 0 || k == 3) {
      const int nsub = (k == 0 && l == 0) ? 2 : 1;
      for (int sub = 0; sub < nsub; ++sub) phase_gemm(p, l, (k == 3) ? 2 : sub, cperm, lds);
    } else if (k == 1) phase_b1(p, l, xcd_arg, smem);
    else if (k == 2) phase_att(p, l, xcd_arg, smem);
    else phase_ln(p, l);
    if (ph + 1 < DEPTH * 5) xcd_barrier(xb);
  }
}

extern "C" void kernel_launch(void* const* d_in, const int* in_sizes, int n_in, void* d_out,
                              int out_size, void* d_ws, size_t ws_size, hipStream_t stream) {
  static int grid_blocks = 0;
  if (!grid_blocks) {
    int dev = 0, cus = 0, per_cu = 0;
    (void)hipGetDevice(&dev);
    (void)hipDeviceGetAttribute(&cus, hipDeviceAttributeMultiprocessorCount, dev);
    if (hipFuncSetAttribute((const void*)fwd_megakernel, hipFuncAttributeMaxDynamicSharedMemorySize, SM_TOTAL) != hipSuccess) {
      fprintf(stderr, "kernel_launch: hipFuncSetAttribute failed (%d bytes of dynamic LDS)\n", SM_TOTAL); return; }
    if (hipOccupancyMaxActiveBlocksPerMultiprocessor(&per_cu, (const void*)fwd_megakernel, NTHR, SM_TOTAL) != hipSuccess || per_cu < 1) {
      fprintf(stderr, "kernel_launch: occupancy query failed\n"); return; }
    grid_blocks = cus;
  }
  if (ws_size < WS_NEEDED) { fprintf(stderr, "workspace too small: %zu < %zu\n", ws_size, (size_t)WS_NEEDED); return; }
  Params p{};
  p.x = (const float*)d_in[0]; p.mem = (const float*)d_in[1]; p.pos = (const int*)d_in[2];
  p.w_in = (const float*)d_in[3]; p.rel_bias = (const float*)d_in[4]; p.q_norm = (const float*)d_in[5];
  p.w_uq = (const float*)d_in[6]; p.kv_norm = (const float*)d_in[7]; p.w_ukv = (const float*)d_in[8];
  p.sinks = (const float*)d_in[9]; p.w_mem_kv = (const float*)d_in[10]; p.w_out = (const float*)d_in[11];
  p.ln_g = (const float*)d_in[12]; p.ln_b = (const float*)d_in[13];
  p.out = (float*)d_out; p.ws = (char*)d_ws;
  (void)hipMemsetAsync((char*)d_ws + OFF_BAR, 0, ZERO_BYTES, stream);
  void* args[] = {&p};
  hipError_t e = hipLaunchCooperativeKernel((void*)fwd_megakernel, dim3(grid_blocks), dim3(NTHR), args, SM_TOTAL, stream);
  if (e != hipSuccess) fprintf(stderr, "cooperative launch failed: %s (grid %d)\n", hipGetErrorString(e), grid_blocks);
}
```

```cpp
#include <hip/hip_runtime.h>
#include <hip/hip_cooperative_groups.h>
#include <cstdio>
#include <type_traits>
namespace cg = cooperative_groups;

typedef unsigned short u16;
typedef short bf16x8 __attribute__((ext_vector_type(8)));
typedef float f32x16 __attribute__((ext_vector_type(16)));
typedef __bf16 bf16x2_t __attribute__((ext_vector_type(2)));
typedef float f32x2_t __attribute__((ext_vector_type(2)));
typedef unsigned u32x4 __attribute__((ext_vector_type(4)));
typedef unsigned u32x2 __attribute__((ext_vector_type(2)));
typedef float f32x4 __attribute__((ext_vector_type(4)));

#define DI __device__ __forceinline__
#define MFMA(a, b, c) __builtin_amdgcn_mfma_f32_32x32x16_bf16((a), (b), (c), 0, 0, 0)

constexpr int T_TOK = 65536;
constexpr int SEQ = 4096;
constexpr int NBATCH = 16;
constexpr int DM = 1024;
constexpr int NP = 3072;
constexpr int PW = 2912;
constexpr int DEPTH = 4;
constexpr int NTHR = 512;
constexpr int C_AQ = 0, C_AK = 256, C_AV = 512, C_AG = 768;
constexpr int C_CQ = 1024, C_CK = 1280, C_CV = 1408, C_CG = 1536;
constexpr int C_MQ = 1792, C_MG = 2048;
constexpr int C_BG = 2304, C_BCQ = 2560, C_BCKV = 2752, C_BKR = 2880;

constexpr float LOG2E = 1.4426950408889634f;
constexpr float QS64 = 0.125f * LOG2E;
constexpr float QS96 = 0.10206207261596575f * LOG2E;

constexpr size_t AL(size_t x) { return (x + 255) & ~(size_t)255; }
constexpr size_t OFF_WIN = 0;
constexpr size_t OFF_WOUT = OFF_WIN + AL((size_t)DEPTH * NP * DM * 2);
constexpr size_t OFF_WUQ = OFF_WOUT + AL((size_t)DEPTH * DM * DM * 2);
constexpr size_t OFF_WUKV = OFF_WUQ + AL((size_t)DEPTH * 384 * 192 * 2);
constexpr size_t OFF_WMKV = OFF_WUKV + AL((size_t)DEPTH * 512 * 128 * 2);
constexpr size_t OFF_MEMB = OFF_WMKV + AL((size_t)DEPTH * 512 * 1024 * 2);
constexpr size_t OFF_KVMEM = OFF_MEMB + AL((size_t)4096 * 1024 * 2);
constexpr size_t OFF_VTMEM = OFF_KVMEM + AL((size_t)4096 * 2048 * 2);
constexpr size_t OFF_COS64 = OFF_VTMEM + AL((size_t)DEPTH * 4096 * 256 * 2);
constexpr size_t OFF_SIN64 = OFF_COS64 + AL((size_t)T_TOK * 32 * 4);
constexpr size_t OFF_COS32 = OFF_SIN64 + AL((size_t)T_TOK * 32 * 4);
constexpr size_t OFF_SIN32 = OFF_COS32 + AL((size_t)T_TOK * 16 * 4);
constexpr size_t OFF_XB = OFF_SIN32 + AL((size_t)T_TOK * 16 * 4);
constexpr size_t OFF_PROJ = OFF_XB + AL((size_t)T_TOK * DM * 2);
constexpr size_t OFF_VTA = OFF_PROJ + AL((size_t)T_TOK * NP * 2);
constexpr size_t OFF_VTC = OFF_VTA + AL((size_t)T_TOK * 256 * 2);
constexpr size_t OFF_VTB = OFF_VTC + AL((size_t)T_TOK * 128 * 2);
constexpr size_t OFF_QB = OFF_VTB + AL((size_t)T_TOK * 256 * 2);
constexpr size_t OFF_KB = OFF_QB + AL((size_t)T_TOK * 384 * 2);
constexpr size_t OFF_GATED = OFF_KB + AL((size_t)T_TOK * 384 * 2);
constexpr size_t OFF_STATS = OFF_GATED + AL((size_t)T_TOK * DM * 2);
constexpr size_t OFF_BAR = OFF_STATS + AL((size_t)T_TOK * 2 * 4);
constexpr size_t BAR_BYTES = 3456 * 4;
constexpr size_t OFF_WQ = OFF_BAR + AL(BAR_BYTES);
constexpr size_t WQ_BYTES = (size_t)DEPTH * 4 * 8 * 64;
constexpr size_t ZERO_BYTES = (OFF_WQ + WQ_BYTES) - OFF_BAR;
constexpr size_t WS_NEEDED = OFF_WQ + WQ_BYTES;

constexpr int SM_STAGE_BYTES = 131072;
constexpr int GROW = 40;
constexpr int G_STAGE = 384 * GROW * 2;
constexpr int HALF_GEMM = 2 * G_STAGE;
constexpr int VROWB = 144;
constexpr int ATT_STAGE = 17408 + 128 * VROWB;
constexpr int HALF_ATT = 2 * ATT_STAGE;
constexpr int SM_K = 0;
constexpr int SM_VT = 17408;
constexpr int SM_BIAS = 2 * HALF_ATT;
constexpr int SM_RS = SM_BIAS + 4128;
constexpr int SM_XB = SM_RS + 2048;
constexpr int SM_ITEM = SM_XB + 16;
constexpr int SM_TOTAL = SM_ITEM + 16;

struct Params {
  const float* x; const float* mem; const int* pos;
  const float* w_in; const float* rel_bias; const float* q_norm; const float* w_uq;
  const float* kv_norm; const float* w_ukv; const float* sinks; const float* w_mem_kv;
  const float* w_out; const float* ln_g; const float* ln_b;
  float* out; char* ws;
  int use_cg_sync; int pad_;
};

DI float bf2f(u16 v) { return __uint_as_float(((unsigned)v) << 16); }
DI unsigned pack2(float a, float b) {
  f32x2_t v = {a, b};
  bf16x2_t r = __builtin_convertvector(v, bf16x2_t);
  return __builtin_bit_cast(unsigned, r);
}
DI u32x4 mk4(unsigned a, unsigned b, unsigned c, unsigned d) { u32x4 v = {a, b, c, d}; return v; }
DI u32x2 mk2(unsigned a, unsigned b) { u32x2 v = {a, b}; return v; }
DI int opaque_tid() { int t = threadIdx.x; asm volatile("" : "+v"(t)); return t; }
typedef const __attribute__((address_space(1))) char* gptr_t;
DI gptr_t uniform_ptr(const void* p) {
  const unsigned long long v = (unsigned long long)p;
  const unsigned lo = __builtin_amdgcn_readfirstlane((unsigned)v), hi = __builtin_amdgcn_readfirstlane((unsigned)(v >> 32));
  return (gptr_t)(((unsigned long long)hi << 32) | lo);
}
DI float lo_f(unsigned u) { return __uint_as_float(u << 16); }
DI float hi_f(unsigned u) { return __uint_as_float(u & 0xffff0000u); }
DI float fast_exp2(float x) { return __builtin_amdgcn_exp2f(x); }
DI float silu_f(float g) { return g * __builtin_amdgcn_rcpf(1.0f + fast_exp2(-g * LOG2E)); }

DI int win_colmap(int n, float& sc) {
  sc = 1.0f;
  if (n < 1024) { if (n < 256) sc = QS64; return n; }
  if (n < 1280) { sc = QS64; return 1632 + (n - 1024); }
  if (n < 1408) return 1888 + (n - 1280);
  if (n < 1536) return 2016 + (n - 1408);
  if (n < 1792) return 2144 + (n - 1536);
  if (n < 2048) { sc = QS64; return 2400 + (n - 1792); }
  if (n < 2304) return 2656 + (n - 2048);
  if (n < 2560) return 1376 + (n - 2304);
  if (n < 2752) return 1024 + (n - 2560);
  if (n < 2880) return 1216 + (n - 2752);
  if (n < 2912) return 1344 + (n - 2880);
  sc = 0.0f; return 0;
}

DI void transpose_tile(const Params& p, int l, int job, int kt, int nt, float* tile, int tid) {
  const float* src; int lds_; u16* dst; int ldd; const float* kscale = nullptr; float kconst = 1.0f;
  char* ws = p.ws;
  if (job == 0) { src = p.w_in + (size_t)l * DM * PW; lds_ = PW; dst = (u16*)(ws + OFF_WIN) + (size_t)l * NP * DM; ldd = DM; }
  else if (job == 1) { src = p.w_out + (size_t)l * DM * DM; lds_ = DM; dst = (u16*)(ws + OFF_WOUT) + (size_t)l * DM * DM; ldd = DM; }
  else if (job == 2) { src = p.w_uq + (size_t)l * 192 * 384; lds_ = 384; dst = (u16*)(ws + OFF_WUQ) + (size_t)l * 384 * 192; ldd = 192; kscale = p.q_norm + l * 192; kconst = QS96; }
  else if (job == 3) { src = p.w_ukv + (size_t)l * 128 * 512; lds_ = 512; dst = (u16*)(ws + OFF_WUKV) + (size_t)l * 512 * 128; ldd = 128; kscale = p.kv_norm + l * 128; }
  else { src = p.w_mem_kv + (size_t)l * 1024 * 512; lds_ = 512; dst = (u16*)(ws + OFF_WMKV) + (size_t)l * 512 * 1024; ldd = 1024; }
  const int k0 = kt * 64, n0 = nt * 64;
  {
    const int nx = tid & 63;
    const int n = n0 + nx;
    int col; float sc = 1.0f;
    if (job == 0) col = win_colmap(n, sc);
    else if (job == 2) col = (n < 256) ? ((n >> 6) * 96 + (n & 63)) : (((n - 256) >> 5) * 96 + 64 + ((n - 256) & 31));
    else if (job == 3) col = (n < 256) ? ((n >> 6) * 128 + (n & 63)) : (((n - 256) >> 6) * 128 + 64 + ((n - 256) & 63));
    else col = n;
    sc *= kconst;
    float v[16];
#pragma unroll
    for (int i = 0; i < 16; ++i) v[i] = __builtin_nontemporal_load(&src[(size_t)(k0 + i * 4 + (tid >> 6)) * lds_ + col]);
#pragma unroll
    for (int i = 0; i < 16; ++i) {
      const int ky = i * 4 + (tid >> 6);
      float x = v[i] * sc;
      if (kscale) x *= kscale[k0 + ky];
      tile[ky * 65 + nx] = x;
    }
  }
  __syncthreads();
  {
    const int n = tid >> 2, kc = (tid & 3) * 16;
    unsigned w[8];
#pragma unroll
    for (int i = 0; i < 8; ++i) w[i] = pack2(tile[(kc + 2 * i) * 65 + n], tile[(kc + 2 * i + 1) * 65 + n]);
    u32x4* d = (u32x4*)(dst + (size_t)(n0 + n) * ldd + k0 + kc);
    d[0] = mk4(w[0], w[1], w[2], w[3]);
    d[1] = mk4(w[4], w[5], w[6], w[7]);
  }
  __syncthreads();
}

DI void sincos_reduced(double ang, float& c, float& s) {
  const double TWO_PI = 6.283185307179586476925287;
  double k = rint(ang * (1.0 / TWO_PI));
  double r = fma(-k, TWO_PI, ang);
  double r2 = r * r;
  double sp = -1.0 / 15511210043330985984000000.0;
  double ss = 1.0 / 15511210043330985984000000.0;
  ss = fma(ss, r2, -1.0 / 25852016738884976640000.0);
  ss = fma(ss, r2, 1.0 / 51090942171709440000.0);
  ss = fma(ss, r2, -1.0 / 121645100408832000.0);
  ss = fma(ss, r2, 1.0 / 355687428096000.0);
  ss = fma(ss, r2, -1.0 / 1307674368000.0);
  ss = fma(ss, r2, 1.0 / 6227020800.0);
  ss = fma(ss, r2, -1.0 / 39916800.0);
  ss = fma(ss, r2, 1.0 / 362880.0);
  ss = fma(ss, r2, -1.0 / 5040.0);
  ss = fma(ss, r2, 1.0 / 120.0);
  ss = fma(ss, r2, -1.0 / 6.0);
  ss = fma(ss, r2, 1.0);
  ss *= r;
  (void)sp;
  double cc = 1.0 / 620448401733239439360000.0;
  cc = fma(cc, r2, -1.0 / 1124000727777607680000.0);
  cc = fma(cc, r2, 1.0 / 2432902008176640000.0);
  cc = fma(cc, r2, -1.0 / 6402373705728000.0);
  cc = fma(cc, r2, 1.0 / 20922789888000.0);
  cc = fma(cc, r2, -1.0 / 87178291200.0);
  cc = fma(cc, r2, 1.0 / 479001600.0);
  cc = fma(cc, r2, -1.0 / 3628800.0);
  cc = fma(cc, r2, 1.0 / 40320.0);
  cc = fma(cc, r2, -1.0 / 720.0);
  cc = fma(cc, r2, 1.0 / 24.0);
  cc = fma(cc, r2, -0.5);
  cc = fma(cc, r2, 1.0);
  c = (float)cc; s = (float)ss;
}

DI void phase0(const Params& p, char* smem) {
  const int tid = opaque_tid();
  const size_t gtid = (size_t)blockIdx.x * NTHR + tid;
  const size_t gn = (size_t)gridDim.x * NTHR;
  char* ws = p.ws;
  {
    u16* xb = (u16*)(ws + OFF_XB);
    const size_t n8 = (size_t)T_TOK * DM / 8;
    for (size_t i = gtid; i < n8; i += 4 * gn) {
      f32x4 a[4], b[4];
#pragma unroll
      for (int u = 0; u < 4; ++u) { const size_t k = (i + u * gn < n8) ? i + u * gn : i; a[u] = __builtin_nontemporal_load(&((const f32x4*)p.x)[2 * k]); b[u] = __builtin_nontemporal_load(&((const f32x4*)p.x)[2 * k + 1]); }
#pragma unroll
      for (int u = 0; u < 4; ++u) { const size_t k = (i + u * gn < n8) ? i + u * gn : i; ((u32x4*)xb)[k] = mk4(pack2(a[u].x, a[u].y), pack2(a[u].z, a[u].w), pack2(b[u].x, b[u].y), pack2(b[u].z, b[u].w)); }
    }
    u16* mb = (u16*)(ws + OFF_MEMB);
    const size_t m8 = (size_t)4096 * 1024 / 8;
    for (size_t i = gtid; i < m8; i += gn) {
      const f32x4 a = ((const f32x4*)p.mem)[2 * i], b = ((const f32x4*)p.mem)[2 * i + 1];
      ((u32x4*)mb)[i] = mk4(pack2(a.x, a.y), pack2(a.z, a.w), pack2(b.x, b.y), pack2(b.z, b.w));
    }
  }
  {
    float* c64 = (float*)(ws + OFF_COS64); float* s64 = (float*)(ws + OFF_SIN64);
    float* c32 = (float*)(ws + OFF_COS32); float* s32 = (float*)(ws + OFF_SIN32);
    const double L2T = 13.287712379549449;
    float* invf = (float*)(smem + 40960);
    if (tid < 48) invf[tid] = (tid < 32) ? (float)exp2(-(double)(2 * tid) / 64.0 * L2T) : (float)exp2(-(double)(2 * (tid - 32)) / 32.0 * L2T);
    __syncthreads();
    for (size_t i = gtid; i < (size_t)T_TOK * 48; i += gn) {
      const int tok = (int)(i / 48), j = (int)(i % 48);
      const float angf = (float)p.pos[tok] * invf[j];
      float c, s;
      sincos_reduced((double)angf, c, s);
      if (j < 32) { c64[(size_t)tok * 32 + j] = c; s64[(size_t)tok * 32 + j] = s; }
      else { c32[(size_t)tok * 16 + (j - 32)] = c; s32[(size_t)tok * 16 + (j - 32)] = s; }
    }
    __syncthreads();
  }
  {
    const int hf = tid >> 8, tidh = tid & 255;
    float* tile = (float*)(smem + hf * 16896);
    for (int t2 = blockIdx.x; t2 < DEPTH * 1186 / 2; t2 += gridDim.x) {
      const int t = 2 * t2 + hf;
      const int l = t / 1186; int u = t % 1186;
      int job, kt, nt;
      if (u < 768) { job = 0; kt = u / 48; nt = u % 48; }
      else if ((u -= 768) < 256) { job = 1; kt = u / 16; nt = u % 16; }
      else if ((u -= 256) < 18) { job = 2; kt = u / 6; nt = u % 6; }
      else if ((u -= 18) < 16) { job = 3; kt = u / 8; nt = u % 8; }
      else { u -= 16; job = 4; kt = u / 8; nt = u % 8; }
      transpose_tile(p, l, job, kt, nt, tile, tidh);
    }
  }
}

namespace pg8 {
#define PG8_LAS __attribute__((address_space(3)))
typedef unsigned short bf16_t;
typedef short bf16x8 __attribute__((ext_vector_type(8)));
typedef float f32x4 __attribute__((ext_vector_type(4)));
typedef unsigned u32x4 __attribute__((ext_vector_type(4)));
constexpr int BM = 256, BK = 64, HALF = 128, HTB = HALF * BK * 2  , STAGE_BYTES = 8 * HTB, NXCD = 8, WGM = 8;

__host__ __device__ __forceinline__ int lds_byte(int r, int c) { const int st = (r >> 4) * 2 + (c >> 5), rr = r & 15, cc = c & 31, ob = rr * 64 + cc * 2; return st * 1024 + (ob ^ (((ob >> 9) & 1) << 5)); }
__host__ __device__ __forceinline__ void stage_rc(int b, int& R, int& C) { const int st = b / 1024, sb = b % 1024, swz = sb ^ (((sb >> 9) & 1) << 5); R = (st >> 1) * 16 + swz / 64; C = (st & 1) * 32 + (swz % 64) / 2; }
__host__ __device__ __forceinline__ int perm32(int rho) { const int n = rho >> 4, i = rho & 15; return 8 * (i >> 2) + 4 * n + (i & 3); }

typedef PG8_LAS unsigned char* PG8_LAS_T;
struct Unit { int pm, pn; };
struct Gemm { const bf16_t* A; const bf16_t* Bt; int M, N, K; };

struct StaticOrder {
    int nM, nN, nwg, G, c;
    __host__ __device__ void init(int M, int N, int G_, int c_) { nM = M / BM; nN = N / BM; nwg = nM * nN; G = G_; c = c_; }
    __host__ __device__ bool next(int i, Unit& u) const {
        const long L = (long)i * G + c; if (L >= nwg) return false;
        int wgid = (int)L; { const int q = nwg / NXCD, r = nwg % NXCD, xcd = wgid % NXCD, off = wgid / NXCD; wgid = (xcd < r ? xcd * (q + 1) : r * (q + 1) + (xcd - r) * q) + off; }
        const int nig = WGM * nN, gid = wgid / nig, fm = gid * WGM, gsz = (nM - fm) < WGM ? (nM - fm) : WGM;
        u.pm = fm + ((wgid % nig) % gsz); u.pn = (wgid % nig) / gsz; return true;
    }
    __device__ __forceinline__ void a_ready(const Unit&) const {}
    __device__ __forceinline__ void done(const Unit&) const {}
};
__device__ __forceinline__ unsigned cvt_pk_bf16(float lo, float hi) { unsigned r; asm volatile("v_cvt_pk_bf16_f32 %0, %1, %2" : "=v"(r) : "v"(lo), "v"(hi)); return r; }

struct EpiBf16 {
    static constexpr bool PERM = true, AFTER_DRAIN = false;
    bf16_t* O; int ldc; int nt;
    __device__ __forceinline__ void operator()(const f32x4 (&acc)[2][2][4][2], const Unit& u, int wr, int wc, int fr, int fq) const {
        const int row0 = u.pm * BM + wr * 64 + fr; const int col0 = u.pn * BM + wc * 32 + 8 * fq;
#pragma unroll
        for (int ai = 0; ai < 2; ++ai)
#pragma unroll
            for (int m = 0; m < 4; ++m) { bf16_t* rowp = O + (size_t)(row0 + ai * HALF + m * 16) * ldc + col0;
#pragma unroll
                for (int bj = 0; bj < 2; ++bj) { const f32x4 v0 = acc[ai][bj][m][0], v1 = acc[ai][bj][m][1];
                    u32x4 w; w.x = cvt_pk_bf16(v0[0], v0[1]); w.y = cvt_pk_bf16(v0[2], v0[3]); w.z = cvt_pk_bf16(v1[0], v1[1]); w.w = cvt_pk_bf16(v1[2], v1[3]);
                    if (nt) __builtin_nontemporal_store(w, (u32x4*)(rowp + bj * HALF)); else *(u32x4*)(rowp + bj * HALF) = w; } }
    }
};
template <bool LN> struct EpiRes {
    static constexpr bool PERM = false, AFTER_DRAIN = false;
    static constexpr float alpha = 1.681792830507429f;
    const float* base; float* out; int ldc; const float* stats; const float* g; const float* b;
    __device__ __forceinline__ void operator()(const f32x4 (&acc)[2][2][4][2], const Unit& u, int wr, int wc, int fr, int fq) const {
        const int row0 = u.pm * BM + wr * 64 + fr, col0 = u.pn * BM + wc * 32 + 4 * fq;
        f32x4 gv[2][2], bv[2][2];
        if constexpr (LN) {
#pragma unroll
            for (int bj = 0; bj < 2; ++bj)
#pragma unroll
                for (int n = 0; n < 2; ++n) { gv[bj][n] = *(const f32x4*)(g + col0 + bj * HALF + n * 16) * alpha; bv[bj][n] = *(const f32x4*)(b + col0 + bj * HALF + n * 16) * alpha; }
        }
#pragma unroll
        for (int ai = 0; ai < 2; ++ai)
#pragma unroll
            for (int m = 0; m < 4; ++m) { const int row = row0 + ai * HALF + m * 16; const size_t off = (size_t)row * ldc + col0;
                f32x4 bs[2][2];
#pragma unroll
                for (int bj = 0; bj < 2; ++bj)
#pragma unroll
                    for (int n = 0; n < 2; ++n) bs[bj][n] = *(const f32x4*)(base + off + bj * HALF + n * 16);
                if constexpr (LN) {
                    const float mean = stats[2 * row], rstd = stats[2 * row + 1];
#pragma unroll
                    for (int bj = 0; bj < 2; ++bj)
#pragma unroll
                        for (int n = 0; n < 2; ++n) *(f32x4*)(out + off + bj * HALF + n * 16) = (bs[bj][n] - mean) * rstd * gv[bj][n] + bv[bj][n] + acc[ai][bj][m][n];
                } else {
#pragma unroll
                    for (int bj = 0; bj < 2; ++bj)
#pragma unroll
                        for (int n = 0; n < 2; ++n) *(f32x4*)(out + off + bj * HALF + n * 16) = bs[bj][n] * alpha + acc[ai][bj][m][n];
                }
                asm volatile("" ::: "memory"); }
    }
};

template <class Epi, class Sched, bool STAMP = false>
__device__ __forceinline__ void gemm_phase(PG8_LAS unsigned char* lds, const Gemm g, const Sched& S, const Epi& E, unsigned long long* stamps) {
    int tid = threadIdx.x; asm volatile("" : "+v"(tid));
    const int wid = __builtin_amdgcn_readfirstlane(tid >> 6), lane = tid & 63, wr = wid >> 2, wc = wid & 3, fr = lane & 15, fq = lane >> 4;
    const int K = g.K, nt = K / BK;
    int ts_lo = 0, ts_hi = 0, nts = 0; const unsigned long long rt_entry = STAMP ? (unsigned long long)wall_clock64() : 0ull;
#define PG8_STAMP() do { if (STAMP && wid == 0 && nts < 64) { const unsigned long long _c = (unsigned long long)clock64(); \
        ts_lo = (lane == nts) ? (int)(unsigned)_c : ts_lo; ts_hi = (lane == nts) ? (int)(unsigned)(_c >> 32) : ts_hi; ++nts; } } while (0)
    PG8_STAMP();
    unsigned voffA[2], voffB[2];
#pragma unroll
    for (int i = 0; i < 2; ++i) { int R, C; stage_rc(tid * 16 + i * 8192, R, C); const int Rb = Epi::PERM ? ((R & ~31) + perm32(R & 31)) : R;
        voffA[i] = (unsigned)(R * K + C) * 2u; voffB[i] = (unsigned)(Rb * K + C) * 2u; }
    const size_t kstep = (size_t)(BK * 2);
    const size_t hstep = (size_t)HALF * K * 2;
    const size_t tstep = 2 * hstep;
    const unsigned ldsw = (unsigned)wid * 1024u;
    const int aoff = lds_byte(wr * 64 + fr, fq * 8), boff = lds_byte(wc * 32 + fr, fq * 8);
#define PG8_SA(b, h) (((b) * 2 + (h)) * HTB)
#define PG8_SB(b, h) ((4 + (b) * 2 + (h)) * HTB)
#define PG8_STAGE(bufoff, gbase, voff) do { _Pragma("unroll") for (int _i = 0; _i < 2; ++_i) \
        __builtin_amdgcn_global_load_lds((const unsigned*)((const char*)(gbase) + (voff)[_i]), (PG8_LAS unsigned*)(lds + (bufoff) + ldsw + _i * 8192), 16, 0, 0); } while (0)
#define PG8_LDA(dst, b, h) do { _Pragma("unroll") for (int m = 0; m < 4; ++m) _Pragma("unroll") for (int k = 0; k < 2; ++k) dst[m][k] = *(const PG8_LAS bf16x8*)(lds + PG8_SA(b, h) + aoff + m * 2048 + k * 1024); } while (0)
#define PG8_LDB(dst, b, h) do { _Pragma("unroll") for (int n = 0; n < 2; ++n) _Pragma("unroll") for (int k = 0; k < 2; ++k) dst[n][k] = *(const PG8_LAS bf16x8*)(lds + PG8_SB(b, h) + boff + n * 2048 + k * 1024); } while (0)
#define PG8_MMA(ai, bj, At, Bt) do { __builtin_amdgcn_s_setprio(1); _Pragma("unroll") for (int m = 0; m < 4; ++m) _Pragma("unroll") for (int n = 0; n < 2; ++n) _Pragma("unroll") for (int k = 0; k < 2; ++k) \
        acc[ai][bj][m][n] = __builtin_amdgcn_mfma_f32_16x16x32_bf16(Bt[n][k], At[m][k], acc[ai][bj][m][n], 0, 0, 0); __builtin_amdgcn_s_setprio(0); } while (0)
#define PG8_WAIT_V(n) asm volatile("s_waitcnt vmcnt(" #n ")" ::: "memory")
#define PG8_WAIT_L(n) asm volatile("s_waitcnt lgkmcnt(" #n ")" ::: "memory")
#define PG8_BAR __builtin_amdgcn_s_barrier()
#define PG8_SCHED __builtin_amdgcn_sched_barrier(0)
    Unit cur, nxt; int ui = 0;
    if (!S.next(0, cur)) return;
    f32x4 acc[2][2][4][2];
#pragma unroll
    for (int a = 0; a < 2; ++a)
#pragma unroll
        for (int b = 0; b < 2; ++b)
#pragma unroll
            for (int m = 0; m < 4; ++m)
#pragma unroll
                for (int n = 0; n < 2; ++n) acc[a][b][m][n] = (f32x4){0.f, 0.f, 0.f, 0.f};
    bf16x8 At[4][2], B0[2][2], B1[2][2];
    const char* cA = (const char*)g.A + (size_t)cur.pm * tstep; const char* cB = (const char*)g.Bt + (size_t)cur.pn * tstep;
    S.a_ready(cur);
    PG8_STAGE(PG8_SB(0, 0), cB, voffB); PG8_STAGE(PG8_SA(0, 0), cA, voffA); PG8_STAGE(PG8_SB(0, 1), cB + hstep, voffB); PG8_STAGE(PG8_SA(0, 1), cA + hstep, voffA);
    if (wr == 1) PG8_BAR;
    PG8_WAIT_V(4); PG8_BAR;
    PG8_STAGE(PG8_SB(1, 0), cB + kstep, voffB); PG8_STAGE(PG8_SA(1, 0), cA + kstep, voffA); PG8_STAGE(PG8_SB(1, 1), cB + hstep + kstep, voffB);
    PG8_WAIT_V(6); PG8_BAR;
    PG8_STAMP();
    for (;;) {
        const bool has_next = S.next(ui + 1, nxt);
        const char* nA = has_next ? (const char*)g.A + (size_t)nxt.pm * tstep : cA; const char* nB = has_next ? (const char*)g.Bt + (size_t)nxt.pn * tstep : cB;
        for (int t = 0; t < nt; t += 2) {
            const bool last = (t == nt - 2);
            const char* a1 = cA + (size_t)(t + 1) * kstep;
            const char* a2 = last ? nA : cA + (size_t)(t + 2) * kstep; const char* b2 = last ? nB : cB + (size_t)(t + 2) * kstep;
            const char* a3 = a2 + kstep; const char* b3 = b2 + kstep;
            if (last && has_next) S.a_ready(nxt);
            PG8_LDB(B0, 0, 0); PG8_SCHED; PG8_LDA(At, 0, 0); PG8_STAGE(PG8_SA(1, 1), a1 + hstep, voffA);
            PG8_WAIT_L(8); PG8_BAR; PG8_WAIT_L(0); PG8_MMA(0, 0, At, B0); PG8_BAR; PG8_SCHED;
            PG8_LDB(B1, 0, 1); PG8_STAGE(PG8_SB(0, 0), b2, voffB);
            PG8_BAR; PG8_WAIT_L(0); PG8_MMA(0, 1, At, B1); PG8_BAR;
            PG8_LDA(At, 0, 1); PG8_STAGE(PG8_SA(0, 0), a2, voffA);
            PG8_BAR; PG8_WAIT_L(0); PG8_MMA(1, 0, At, B0); PG8_BAR; PG8_SCHED;
            PG8_STAGE(PG8_SB(0, 1), b2 + hstep, voffB);
            PG8_WAIT_V(6); PG8_BAR; PG8_MMA(1, 1, At, B1); PG8_BAR;
            PG8_LDB(B0, 1, 0); PG8_SCHED; PG8_LDA(At, 1, 0); PG8_STAGE(PG8_SA(0, 1), a2 + hstep, voffA);
            PG8_WAIT_L(8); PG8_BAR; PG8_WAIT_L(0); PG8_MMA(0, 0, At, B0); PG8_BAR; PG8_SCHED;
            PG8_LDB(B1, 1, 1); PG8_STAGE(PG8_SB(1, 0), b3, voffB);
            PG8_BAR; PG8_WAIT_L(0); PG8_MMA(0, 1, At, B1); PG8_BAR;
            PG8_LDA(At, 1, 1); PG8_STAGE(PG8_SA(1, 0), a3, voffA);
            PG8_BAR; PG8_WAIT_L(0); PG8_MMA(1, 0, At, B0); PG8_BAR; PG8_SCHED;
            PG8_STAGE(PG8_SB(1, 1), b3 + hstep, voffB);
            PG8_WAIT_V(6); PG8_BAR; PG8_MMA(1, 1, At, B1); PG8_BAR;
        }
        PG8_STAMP();
        if constexpr (!Epi::AFTER_DRAIN) { E(acc, cur, wr, wc, fr, fq); S.done(cur); }
        PG8_STAMP();
        if (!has_next) break;
#pragma unroll
        for (int a = 0; a < 2; ++a)
#pragma unroll
            for (int b = 0; b < 2; ++b)
#pragma unroll
                for (int m = 0; m < 4; ++m)
#pragma unroll
                    for (int n = 0; n < 2; ++n) acc[a][b][m][n] = (f32x4){0.f, 0.f, 0.f, 0.f};
        cur = nxt; cA = nA; cB = nB; ++ui;
    }
    PG8_WAIT_V(0);
    if (wr == 0) PG8_BAR;
    PG8_BAR;
    if constexpr (Epi::AFTER_DRAIN) { E.fused(acc, cur, wr, wc, fr, fq, lds, wid, lane); S.done(cur); }
    PG8_STAMP();
    if (STAMP && wid == 0) { stamps[lane] = lane < nts ? (((unsigned long long)(unsigned)ts_hi << 32) | (unsigned)ts_lo) : 0ull;
        if (lane == 62) stamps[62] = rt_entry; if (lane == 63) stamps[63] = (unsigned long long)wall_clock64(); }
#undef PG8_STAMP
#undef PG8_SA
#undef PG8_SB
#undef PG8_STAGE
#undef PG8_LDA
#undef PG8_LDB
#undef PG8_MMA
#undef PG8_WAIT_V
#undef PG8_WAIT_L
#undef PG8_BAR
#undef PG8_SCHED
}
}

enum { M_ROW = 0, M_TR = 1, M_UQ = 2, M_UKVK = 3, M_UKVV = 4, M_G3 = 5 };

struct Epi {
  u16* out; int out_ld;
  u16* vt; int seq; int nseg0; int hrows;
  const float* c32; const float* s32;
  const float* xprev; float* xout;
};

template <int MODE>
DI void gemm_tile(const u16* __restrict__ A, int lda, const u16* __restrict__ Bt, int ldb, int K,
                          int m0, int n0, const Epi& e, char* smem, const float* rs, const int tid_in) {
  int tid = tid_in; asm volatile("" : "+v"(tid));
  constexpr bool SWAP = (MODE == M_ROW || MODE == M_UQ || MODE == M_UKVK || MODE == M_G3);
  const int lane = tid & 63, wave = tid >> 6, r = lane & 31, h = lane >> 5;
  const int wm = wave >> 1, wn = wave & 1;
  f32x16 acc[4][2];
#pragma unroll
  for (int i = 0; i < 4; ++i)
#pragma unroll
    for (int j = 0; j < 2; ++j)
#pragma unroll
      for (int q = 0; q < 16; ++q) acc[i][j][q] = 0.f;

  const int lrow = tid >> 2, lch = (tid & 3) * 8;
  const u16* Ag = A + (size_t)(m0 + lrow) * lda + lch;
  const u16* Bg = Bt + (size_t)(n0 + lrow) * ldb + lch;
  u16* Aw = (u16*)smem + lrow * GROW + lch;
  const u16* Ar = (const u16*)smem + (wm * 128 + r) * GROW + 8 * h;
  const u16* Br = (const u16*)smem + (256 + wn * 64 + r) * GROW + 8 * h;
  constexpr int STG = G_STAGE / 2;
  u32x4 r0[6], r1[6];
  const int KT = K >> 5;
#define G_LOAD(R, kt_) { const int k0_ = (kt_) * 32; \
    _Pragma("unroll") for (int i = 0; i < 4; ++i) R[i] = *(const u32x4*)(Ag + (size_t)(64 * i) * lda + k0_); \
    _Pragma("unroll") for (int i = 0; i < 2; ++i) R[4 + i] = *(const u32x4*)(Bg + (size_t)(64 * i) * ldb + k0_); }
#define G_WRITE(R, st_) { \
    _Pragma("unroll") for (int i = 0; i < 4; ++i) *(u32x4*)(Aw + (st_) * STG + (64 * i) * GROW) = R[i]; \
    _Pragma("unroll") for (int i = 0; i < 2; ++i) *(u32x4*)(Aw + (st_) * STG + (256 + 64 * i) * GROW) = R[4 + i]; }
#define G_COMPUTE(st_) { \
    _Pragma("unroll") for (int ks = 0; ks < 2; ++ks) { \
      bf16x8 af[4], bfr[2]; \
      _Pragma("unroll") for (int mb = 0; mb < 4; ++mb) af[mb] = *(const bf16x8*)(Ar + (st_) * STG + mb * 32 * GROW + ks * 16); \
      _Pragma("unroll") for (int nb = 0; nb < 2; ++nb) bfr[nb] = *(const bf16x8*)(Br + (st_) * STG + nb * 32 * GROW + ks * 16); \
      _Pragma("unroll") for (int mb = 0; mb < 4; ++mb) \
        _Pragma("unroll") for (int nb = 0; nb < 2; ++nb) { \
          if (SWAP) acc[mb][nb] = MFMA(bfr[nb], af[mb], acc[mb][nb]); \
          else acc[mb][nb] = MFMA(af[mb], bfr[nb], acc[mb][nb]); } } }
  G_LOAD(r0, 0);
  G_LOAD(r1, 1);
  G_WRITE(r0, 0);
  __syncthreads();
  for (int kt = 0; kt < KT; kt += 2) {
    { const int kn = (kt + 2 < KT) ? kt + 2 : KT - 1; G_LOAD(r0, kn); }
    __builtin_amdgcn_sched_barrier(0);
    G_COMPUTE(0);
    __builtin_amdgcn_sched_barrier(0);
    G_WRITE(r1, 1);
    __syncthreads();
    { const int kn = (kt + 3 < KT) ? kt + 3 : KT - 1; G_LOAD(r1, kn); }
    __builtin_amdgcn_sched_barrier(0);
    G_COMPUTE(1);
    __builtin_amdgcn_sched_barrier(0);
    G_WRITE(r0, 0);
    __syncthreads();
  }
#undef G_LOAD
#undef G_WRITE
#undef G_COMPUTE

  if (MODE == M_G3) {
    const float alpha = 1.681792830507429f;
#pragma unroll
    for (int mb = 0; mb < 4; ++mb) {
      const int m = m0 + wm * 128 + mb * 32 + r;
      const float* xp = e.xprev + (size_t)m * DM + n0 + wn * 64 + 4 * h;
      float* op = e.xout + (size_t)m * DM + n0 + wn * 64 + 4 * h;
      f32x4 xv[2][4];
#pragma unroll
      for (int nb = 0; nb < 2; ++nb)
#pragma unroll
        for (int g = 0; g < 4; ++g) xv[nb][g] = *(const f32x4*)(xp + nb * 32 + 8 * g);
#pragma unroll
      for (int nb = 0; nb < 2; ++nb)
#pragma unroll
        for (int g = 0; g < 4; ++g) {
          f32x4 o;
          o.x = alpha * xv[nb][g].x + acc[mb][nb][4 * g];
          o.y = alpha * xv[nb][g].y + acc[mb][nb][4 * g + 1];
          o.z = alpha * xv[nb][g].z + acc[mb][nb][4 * g + 2];
          o.w = alpha * xv[nb][g].w + acc[mb][nb][4 * g + 3];
          *(f32x4*)(op + nb * 32 + 8 * g) = o;
        }
    }
  } else if (SWAP) {
#pragma unroll
    for (int mb = 0; mb < 4; ++mb) {
      const int ml = wm * 128 + mb * 32 + r;
      const int m = m0 + ml;
      f32x4 rcs[2], rsn[2];
      if (MODE == M_UQ) {
        if (n0 >= 256) {
#pragma unroll
          for (int g = 0; g < 2; ++g) {
            rcs[g] = *(const f32x4*)(e.c32 + (size_t)m * 16 + 8 * g + 4 * h);
            rsn[g] = *(const f32x4*)(e.s32 + (size_t)m * 16 + 8 * g + 4 * h);
          }
        }
      }
      float rsv = 1.0f;
      if (MODE == M_UQ || MODE == M_UKVK) rsv = rs[ml];
#pragma unroll
      for (int nb = 0; nb < 2; ++nb) {
        const int nbase = n0 + wn * 64 + nb * 32;
        if (MODE == M_ROW) {
#pragma unroll
          for (int g = 0; g < 4; ++g) {
            const int n = nbase + 8 * g + 4 * h;
            u32x2 v = mk2(pack2(acc[mb][nb][4 * g], acc[mb][nb][4 * g + 1]), pack2(acc[mb][nb][4 * g + 2], acc[mb][nb][4 * g + 3]));
            *(u32x2*)(e.out + (size_t)m * e.out_ld + n) = v;
          }
        } else if (MODE == M_UKVK) {
#pragma unroll
          for (int g = 0; g < 4; ++g) {
            const int n = nbase + 8 * g + 4 * h;
            u32x2 v = mk2(pack2(acc[mb][nb][4 * g] * rsv, acc[mb][nb][4 * g + 1] * rsv), pack2(acc[mb][nb][4 * g + 2] * rsv, acc[mb][nb][4 * g + 3] * rsv));
            *(u32x2*)(e.out + (size_t)m * 384 + (n >> 6) * 96 + (n & 63)) = v;
          }
        } else if (MODE == M_UQ) {
          if (n0 < 256) {
#pragma unroll
            for (int g = 0; g < 4; ++g) {
              const int n = nbase + 8 * g + 4 * h;
              u32x2 v = mk2(pack2(acc[mb][nb][4 * g] * rsv, acc[mb][nb][4 * g + 1] * rsv), pack2(acc[mb][nb][4 * g + 2] * rsv, acc[mb][nb][4 * g + 3] * rsv));
              *(u32x2*)(e.out + (size_t)m * 384 + (n >> 6) * 96 + (n & 63)) = v;
            }
          } else {
            const int head = wn * 2 + nb;
#pragma unroll
            for (int g = 0; g < 2; ++g) {
              const int d = 8 * g + 4 * h;
              const f32x4 cs = rcs[g];
              const f32x4 sn = rsn[g];
              const float c_[4] = {cs.x, cs.y, cs.z, cs.w}, s_[4] = {sn.x, sn.y, sn.z, sn.w};
              float o1[4], o2[4];
#pragma unroll
              for (int j = 0; j < 4; ++j) {
                const float x1 = acc[mb][nb][4 * g + j] * rsv, x2 = acc[mb][nb][4 * (g + 2) + j] * rsv;
                o1[j] = x1 * c_[j] - x2 * s_[j];
                o2[j] = x2 * c_[j] + x1 * s_[j];
              }
              u16* dst = e.out + (size_t)m * 384 + head * 96 + 64 + d;
              *(u32x2*)dst = mk2(pack2(o1[0], o1[1]), pack2(o1[2], o1[3]));
              *(u32x2*)(dst + 16) = mk2(pack2(o2[0], o2[1]), pack2(o2[2], o2[3]));
            }
          }
        } else if (MODE == M_G3) {
        }
      }
    }
  } else {
    const int b = m0 / e.seq, s0 = m0 % e.seq;
#pragma unroll
    for (int nb = 0; nb < 2; ++nb) {
      const int n = n0 + wn * 64 + nb * 32 + r;
      u16* rowp = e.vt + ((size_t)b * e.hrows + (n - e.nseg0)) * e.seq + s0;
#pragma unroll
      for (int mb = 0; mb < 4; ++mb) {
#pragma unroll
        for (int g = 0; g < 4; ++g) {
          const int ml = wm * 128 + mb * 32 + 8 * g + 4 * h;
          float v0 = acc[mb][nb][4 * g], v1 = acc[mb][nb][4 * g + 1], v2 = acc[mb][nb][4 * g + 2], v3 = acc[mb][nb][4 * g + 3];
          if (MODE == M_UKVV) {
            const f32x4 rv = *(const f32x4*)(rs + ml);
            v0 *= rv.x; v1 *= rv.y; v2 *= rv.z; v3 *= rv.w;
          }
          *(u32x2*)(rowp + ml) = mk2(pack2(v0, v1), pack2(v2, v3));
        }
      }
    }
  }
}

template <int MODE, int KT>
DI void mla_tile8(const u16* __restrict__ Bt, int ldb, int m0, int n0, const Epi& e, char* smem, const float* rs, const int tid_in) {
  int tid = tid_in; asm volatile("" : "+v"(tid));
  constexpr bool SWAP = (MODE == M_ROW || MODE == M_UQ || MODE == M_UKVK || MODE == M_G3);
  const int lane = tid & 63, wave = tid >> 6, r = lane & 31, h = lane >> 5;
  const int wm = wave >> 1, wn = wave & 1;
  f32x16 acc[2][2];
#pragma unroll
  for (int i = 0; i < 2; ++i)
#pragma unroll
    for (int j = 0; j < 2; ++j)
#pragma unroll
      for (int q = 0; q < 16; ++q) acc[i][j][q] = 0.f;
  constexpr int A_STEP = 256 * GROW;
  constexpr int B_STG = 128 * GROW;
  const int lrow = tid >> 2, lch = (tid & 3) * 8;
  const u16* Bg = Bt + (size_t)(n0 + lrow) * ldb + lch;
  u16* Bw = (u16*)smem + KT * A_STEP + lrow * GROW + lch;
  const u16* Ar = (const u16*)smem + (wm * 64 + r) * GROW + 8 * h;
  const u16* Br = (const u16*)smem + KT * A_STEP + (wn * 64 + r) * GROW + 8 * h;
  u32x4 rb[KT];
#pragma unroll
  for (int kt = 0; kt < KT; ++kt) rb[kt] = *(const u32x4*)(Bg + kt * 32);
  *(u32x4*)(Bw) = rb[0];
  __syncthreads();
#pragma unroll
  for (int kt = 0; kt < KT; ++kt) {
    if (kt + 1 < KT) *(u32x4*)(Bw + ((kt + 1) & 1) * B_STG) = rb[kt + 1];
#pragma unroll
    for (int ks = 0; ks < 2; ++ks) {
      bf16x8 af[2], bfr[2];
#pragma unroll
      for (int mb = 0; mb < 2; ++mb) af[mb] = *(const bf16x8*)(Ar + kt * A_STEP + mb * 32 * GROW + ks * 16);
#pragma unroll
      for (int nb = 0; nb < 2; ++nb) bfr[nb] = *(const bf16x8*)(Br + (kt & 1) * B_STG + nb * 32 * GROW + ks * 16);
#pragma unroll
      for (int mb = 0; mb < 2; ++mb)
#pragma unroll
        for (int nb = 0; nb < 2; ++nb) {
          if (SWAP) acc[mb][nb] = MFMA(bfr[nb], af[mb], acc[mb][nb]);
          else acc[mb][nb] = MFMA(af[mb], bfr[nb], acc[mb][nb]);
        }
    }
    __syncthreads();
  }

  if (MODE == M_G3) {
    const float alpha = 1.681792830507429f;
#pragma unroll
    for (int mb = 0; mb < 2; ++mb) {
      const int m = m0 + wm * 64 + mb * 32 + r;
      const float* xp = e.xprev + (size_t)m * DM + n0 + wn * 64 + 4 * h;
      float* op = e.xout + (size_t)m * DM + n0 + wn * 64 + 4 * h;
      f32x4 xv[2][4];
#pragma unroll
      for (int nb = 0; nb < 2; ++nb)
#pragma unroll
        for (int g = 0; g < 4; ++g) xv[nb][g] = *(const f32x4*)(xp + nb * 32 + 8 * g);
#pragma unroll
      for (int nb = 0; nb < 2; ++nb)
#pragma unroll
        for (int g = 0; g < 4; ++g) {
          f32x4 o;
          o.x = alpha * xv[nb][g].x + acc[mb][nb][4 * g];
          o.y = alpha * xv[nb][g].y + acc[mb][nb][4 * g + 1];
          o.z = alpha * xv[nb][g].z + acc[mb][nb][4 * g + 2];
          o.w = alpha * xv[nb][g].w + acc[mb][nb][4 * g + 3];
          *(f32x4*)(op + nb * 32 + 8 * g) = o;
        }
    }
  } else if (SWAP) {
#pragma unroll
    for (int mb = 0; mb < 2; ++mb) {
      const int ml = wm * 64 + mb * 32 + r;
      const int m = m0 + ml;
      f32x4 rcs[2], rsn[2];
      if (MODE == M_UQ) {
        if (n0 >= 256) {
#pragma unroll
          for (int g = 0; g < 2; ++g) {
            rcs[g] = *(const f32x4*)(e.c32 + (size_t)m * 16 + 8 * g + 4 * h);
            rsn[g] = *(const f32x4*)(e.s32 + (size_t)m * 16 + 8 * g + 4 * h);
          }
        }
      }
      float rsv = 1.0f;
      if (MODE == M_UQ || MODE == M_UKVK) rsv = rs[ml];
#pragma unroll
      for (int nb = 0; nb < 2; ++nb) {
        const int nbase = n0 + wn * 64 + nb * 32;
        if (MODE == M_ROW) {
#pragma unroll
          for (int g = 0; g < 4; ++g) {
            const int n = nbase + 8 * g + 4 * h;
            u32x2 v = mk2(pack2(acc[mb][nb][4 * g], acc[mb][nb][4 * g + 1]), pack2(acc[mb][nb][4 * g + 2], acc[mb][nb][4 * g + 3]));
            *(u32x2*)(e.out + (size_t)m * e.out_ld + n) = v;
          }
        } else if (MODE == M_UKVK) {
#pragma unroll
          for (int g = 0; g < 4; ++g) {
            const int n = nbase + 8 * g + 4 * h;
            u32x2 v = mk2(pack2(acc[mb][nb][4 * g] * rsv, acc[mb][nb][4 * g + 1] * rsv), pack2(acc[mb][nb][4 * g + 2] * rsv, acc[mb][nb][4 * g + 3] * rsv));
            *(u32x2*)(e.out + (size_t)m * 384 + (n >> 6) * 96 + (n & 63)) = v;
          }
        } else if (MODE == M_UQ) {
          if (n0 < 256) {
#pragma unroll
            for (int g = 0; g < 4; ++g) {
              const int n = nbase + 8 * g + 4 * h;
              u32x2 v = mk2(pack2(acc[mb][nb][4 * g] * rsv, acc[mb][nb][4 * g + 1] * rsv), pack2(acc[mb][nb][4 * g + 2] * rsv, acc[mb][nb][4 * g + 3] * rsv));
              *(u32x2*)(e.out + (size_t)m * 384 + (n >> 6) * 96 + (n & 63)) = v;
            }
          } else {
            const int head = wn * 2 + nb;
#pragma unroll
            for (int g = 0; g < 2; ++g) {
              const int d = 8 * g + 4 * h;
              const f32x4 cs = rcs[g];
              const f32x4 sn = rsn[g];
              const float c_[4] = {cs.x, cs.y, cs.z, cs.w}, s_[4] = {sn.x, sn.y, sn.z, sn.w};
              float o1[4], o2[4];
#pragma unroll
              for (int j = 0; j < 4; ++j) {
                const float x1 = acc[mb][nb][4 * g + j] * rsv, x2 = acc[mb][nb][4 * (g + 2) + j] * rsv;
                o1[j] = x1 * c_[j] - x2 * s_[j];
                o2[j] = x2 * c_[j] + x1 * s_[j];
              }
              u16* dst = e.out + (size_t)m * 384 + head * 96 + 64 + d;
              *(u32x2*)dst = mk2(pack2(o1[0], o1[1]), pack2(o1[2], o1[3]));
              *(u32x2*)(dst + 16) = mk2(pack2(o2[0], o2[1]), pack2(o2[2], o2[3]));
            }
          }
        } else if (MODE == M_G3) {
        }
      }
    }
  } else {
    const int b = m0 / e.seq, s0 = m0 % e.seq;
#pragma unroll
    for (int nb = 0; nb < 2; ++nb) {
      const int n = n0 + wn * 64 + nb * 32 + r;
      u16* rowp = e.vt + ((size_t)b * e.hrows + (n - e.nseg0)) * e.seq + s0;
#pragma unroll
      for (int mb = 0; mb < 2; ++mb) {
#pragma unroll
        for (int g = 0; g < 4; ++g) {
          const int ml = wm * 64 + mb * 32 + 8 * g + 4 * h;
          float v0 = acc[mb][nb][4 * g], v1 = acc[mb][nb][4 * g + 1], v2 = acc[mb][nb][4 * g + 2], v3 = acc[mb][nb][4 * g + 3];
          if (MODE == M_UKVV) {
            const f32x4 rv = *(const f32x4*)(rs + ml);
            v0 *= rv.x; v1 *= rv.y; v2 *= rv.z; v3 *= rv.w;
          }
          *(u32x2*)(rowp + ml) = mk2(pack2(v0, v1), pack2(v2, v3));
        }
      }
    }
  }
}

template <int KT>
DI void mla_load_a(const u16* proj, int m0, int col0, char* smem, const int tid_in) {
  int tid = tid_in; asm volatile("" : "+v"(tid));
  const int lrow = tid >> 2, lch = (tid & 3) * 8;
  const u16* Ag = proj + (size_t)(m0 + lrow) * NP + col0 + lch;
  u32x4 ra[KT][2];
#pragma unroll
  for (int kt = 0; kt < KT; ++kt)
#pragma unroll
    for (int i = 0; i < 2; ++i) ra[kt][i] = *(const u32x4*)(Ag + (size_t)(128 * i) * NP + kt * 32);
  u16* Aw = (u16*)smem + lrow * GROW + lch;
#pragma unroll
  for (int kt = 0; kt < KT; ++kt)
#pragma unroll
    for (int i = 0; i < 2; ++i) *(u32x4*)(Aw + kt * (256 * GROW) + (128 * i) * GROW) = ra[kt][i];
}

template <int KDIM>
DI void compute_rs(const u16* proj, int m0, int col0, float* rs, const int tid_in) {
  int tid = tid_in; asm volatile("" : "+v"(tid));
  const u16* rowp = proj + (size_t)(m0 + tid) * NP + col0;
  u32x4 v[KDIM / 8];
#pragma unroll
  for (int c = 0; c < KDIM / 8; ++c) v[c] = *(const u32x4*)(rowp + c * 8);
  float ss = 0.f;
#pragma unroll
  for (int c = 0; c < KDIM / 8; ++c) {
    const unsigned w[4] = {v[c].x, v[c].y, v[c].z, v[c].w};
#pragma unroll
    for (int i = 0; i < 4; ++i) { const float a = lo_f(w[i]), b = hi_f(w[i]); ss += a * a + b * b; }
  }
  rs[tid] = rsqrtf(ss / (float)KDIM + 1e-6f);
}

struct AttnBlk {
  const u16* k; int k_ld;
  const u16* vt; int vt_ld;
  int kt_begin, kt_end;
  int c;
};
struct AttnWave {
  const u16* q; int q_ld;
  const u16* gate;
  u16* out;
  int hoff;
  int my_kt_end;
  float m_init; float l_init;
  const float* bias;
  int qi0;
};

#ifndef ATT_HINTS
#define ATT_HINTS 1
#endif
template <int DQK, int NH, int MODE, int PROBE = 0>
DI void attn_item(const AttnBlk& ab, const AttnWave& aw, char* smem, const int tid_in) {
  int tid = tid_in; asm volatile("" : "+v"(tid));
  constexpr int KCOLS = NH * DQK;
  constexpr int KROWB = (KCOLS + 8) * 2;
  constexpr int CPR = KCOLS / 8;
  constexpr int KTOT = 64 * CPR;
  constexpr int NKC = (KTOT + 511) / 512;
  constexpr int NVC = NH;
  constexpr int KIMG = 64 * KROWB;
  constexpr int STAGE = KIMG + NH * 64 * VROWB;
  constexpr int NKS = DQK / 16;
  constexpr bool DEEP = false;
  const int lane = tid & 63, r = lane & 31, h = lane >> 5;

  bf16x8 qf[NKS];
#pragma unroll
  for (int ks = 0; ks < NKS; ++ks) qf[ks] = *(const bf16x8*)(aw.q + (size_t)r * aw.q_ld + ks * 16 + 8 * h);

  f32x16 o0, o1;
#pragma unroll
  for (int i = 0; i < 16; ++i) { o0[i] = 0.f; o1[i] = 0.f; }
  float l = aw.l_init;
  f32x16 cinit;
#pragma unroll
  for (int i = 0; i < 16; ++i) cinit[i] = 0.f;
  constexpr bool CSHIFT = (NH != 4);
  float msub = 0.f;

  const int t0 = ab.kt_begin, te = ab.kt_end, nt = te - t0;
  const int my_n = aw.my_kt_end - t0;
  const gptr_t kb_ = uniform_ptr(ab.k); const gptr_t vb_ = uniform_ptr(ab.vt);
  const int kld_ = __builtin_amdgcn_readfirstlane(ab.k_ld), vld_ = __builtin_amdgcn_readfirstlane(ab.vt_ld);
  constexpr bool AFFINE = ((CPR & (CPR - 1)) == 0) && (KTOT % 512 == 0);
  unsigned koff[AFFINE ? 1 : NKC], voff[1];
  if constexpr (AFFINE) { koff[0] = (unsigned)((tid / CPR) * kld_ + (tid % CPR) * 8) * 2u; }
  else {
#pragma unroll
    for (int i = 0; i < NKC; ++i) { int id = tid + 512 * i; id = id < KTOT ? id : id - 512; const int row = id / CPR, cc = id % CPR; koff[i] = (unsigned)(row * kld_ + cc * 8) * 2u; }
  }
  voff[0] = (unsigned)((tid >> 3) * vld_ + (tid & 7) * 8) * 2u;
  const unsigned kstr_ = (unsigned)((512 / CPR) * kld_) * 2u, vstr_ = (unsigned)(64 * vld_) * 2u;
  u32x4 rk0[NKC], rv0[NVC], rk1[NKC], rv1[NVC];
#define A_LOADK(RK, j_) { const int t_ = (t0 + (j_) < te) ? t0 + (j_) : te - 1; const gptr_t kp_ = kb_ + (size_t)t_ * 128 * (size_t)kld_; \
    _Pragma("unroll") for (int i = 0; i < NKC; ++i) RK[i] = *(const __attribute__((address_space(1))) u32x4*)(kp_ + (AFFINE ? (size_t)i * kstr_ + koff[0] : (size_t)koff[AFFINE ? 0 : i])); }
#define A_LOADV(RV, j_) { const int t_ = (t0 + (j_) < te) ? t0 + (j_) : te - 1; const gptr_t vp_ = vb_ + (size_t)t_ * 128; \
    _Pragma("unroll") for (int i = 0; i < NVC; ++i) RV[i] = *(const __attribute__((address_space(1))) u32x4*)(vp_ + ((size_t)i * vstr_ + voff[0])); }
#define A_WRITEK(RK, st_) { char* Kw_ = smem + (st_) * STAGE; \
    _Pragma("unroll") for (int i = 0; i < NKC; ++i) { int id = tid + 512 * i; id = id < KTOT ? id : id - 512; const int row = id / CPR, cc = id % CPR; \
      *(u32x4*)(Kw_ + row * KROWB + cc * 16) = RK[i]; } }
#define A_WRITEV(RV, st_) { char* Vw_ = smem + (st_) * STAGE + KIMG; \
    _Pragma("unroll") for (int i = 0; i < NVC; ++i) { const int id = tid + 512 * i, row = id >> 3, cc = id & 7; \
      char* d_ = Vw_ + row * VROWB + (cc >> 1) * 32 + (cc & 1) * 8; \
      *(u32x2*)d_ = mk2(RV[i].x, RV[i].y); *(u32x2*)(d_ + 16) = mk2(RV[i].z, RV[i].w); } }

  const char* kl0 = smem + r * KROWB + (aw.hoff * DQK + 8 * h) * 2;
  const char* vl0 = smem + KIMG + (aw.hoff * 64 + r) * VROWB + h * 16;
  f32x16 sa0, sa1, sb0, sb1;

  auto kload = [&](const int st, bf16x8 (&kf)[2 * NKS]) {
    const char* kl = kl0 + st * STAGE;
#pragma unroll
    for (int ks = 0; ks < NKS; ++ks) { kf[2 * ks] = *(const bf16x8*)(kl + ks * 32); kf[2 * ks + 1] = *(const bf16x8*)(kl + 32 * KROWB + ks * 32); }
  };
  auto qk = [&](const bf16x8 (&kf)[2 * NKS], f32x16& a0, f32x16& a1) {
    a0 = MFMA(kf[0], qf[0], cinit);
    a1 = MFMA(kf[1], qf[0], cinit);
#pragma unroll
    for (int ks = 1; ks < NKS; ++ks) { a0 = MFMA(kf[2 * ks], qf[ks], a0); a1 = MFMA(kf[2 * ks + 1], qf[ks], a1); }
  };
  auto step = [&](const int stk, const int stv, const int kt, f32x16& s0, f32x16& s1, f32x16& n0, f32x16& n1) {
    bf16x8 kf[2 * NKS];
    kload(stk, kf);
    __builtin_amdgcn_sched_barrier(0);
    if (MODE == 1) {
      const int dc = ab.c - kt;
      if (dc >= 3) {
        const float bv = aw.bias[256];
#pragma unroll
        for (int i = 0; i < 16; ++i) { s0[i] += bv; s1[i] += bv; }
      } else {
        const int base = 64 * dc + aw.qi0 + r + 128;
#pragma unroll
        for (int i = 0; i < 16; ++i) {
          const int ki = (i & 3) + 8 * (i >> 2) + 4 * h;
          int i0 = base - ki; i0 = i0 > 256 ? 256 : i0;
          int i1 = base - 32 - ki; i1 = i1 > 256 ? 256 : i1;
          s0[i] += aw.bias[i0];
          s1[i] += aw.bias[i1];
        }
      }
    }
    const char* vl = vl0 + stv * STAGE;
    u32x4 vr[4][2];
#define V_READ(b_) { _Pragma("unroll") for (int db = 0; db < 2; ++db) vr[b_][db] = *(const u32x4*)(vl + (b_) * 32 + db * 32 * VROWB); }
    V_READ(0);
    __builtin_amdgcn_sched_barrier(0);
    qk(kf, n0, n1);
    f32x2_t ps2 = {0.f, 0.f};
#pragma unroll
    for (int i = 0; i < 16; i += 2) {
      if constexpr (CSHIFT) {
        s0[i] = fast_exp2(s0[i]); s0[i + 1] = fast_exp2(s0[i + 1]);
        s1[i] = fast_exp2(s1[i]); s1[i + 1] = fast_exp2(s1[i + 1]);
      } else {
        s0[i] = fast_exp2(s0[i] - msub); s0[i + 1] = fast_exp2(s0[i + 1] - msub);
        s1[i] = fast_exp2(s1[i] - msub); s1[i + 1] = fast_exp2(s1[i + 1] - msub);
      }
      f32x2_t a = {s0[i], s0[i + 1]}, b = {s1[i], s1[i + 1]};
      ps2 += a; ps2 += b;
    }
    l += ps2.x + ps2.y;
#pragma unroll
    for (int kb = 0; kb < 2; ++kb) {
#pragma unroll
      for (int s2 = 0; s2 < 2; ++s2) {
        const int bq = kb * 2 + s2;
        if (bq == 0) { V_READ(1); } else if (bq == 1) { V_READ(2); } else if (bq == 2) { V_READ(3); }
        u32x4 pw;
        if (kb == 0) pw = mk4(pack2(s0[8 * s2], s0[8 * s2 + 1]), pack2(s0[8 * s2 + 2], s0[8 * s2 + 3]), pack2(s0[8 * s2 + 4], s0[8 * s2 + 5]), pack2(s0[8 * s2 + 6], s0[8 * s2 + 7]));
        else pw = mk4(pack2(s1[8 * s2], s1[8 * s2 + 1]), pack2(s1[8 * s2 + 2], s1[8 * s2 + 3]), pack2(s1[8 * s2 + 4], s1[8 * s2 + 5]), pack2(s1[8 * s2 + 6], s1[8 * s2 + 7]));
        const bf16x8 pf = __builtin_bit_cast(bf16x8, pw);
        {
          const bf16x8 vf = __builtin_bit_cast(bf16x8, vr[bq][0]);
          o0 = MFMA(vf, pf, o0);
        }
        {
          const bf16x8 vf = __builtin_bit_cast(bf16x8, vr[bq][1]);
          o1 = MFMA(vf, pf, o1);
        }
      }
    }
#undef V_READ
  };

  constexpr bool PAIR = (NH == 1 && DQK == 96);
  if constexpr (PAIR) {
    A_LOADK(rk0, 0); A_LOADV(rv0, 0); A_LOADK(rk1, 1); A_LOADV(rv1, 1);
    A_WRITEK(rk0, 0); A_WRITEV(rv0, 0); A_WRITEK(rk1, 1); A_WRITEV(rv1, 1);
    A_LOADK(rk0, 2);
    A_WRITEK(rk0, 2);
    A_LOADK(rk0, 3); A_LOADK(rk1, 4); A_LOADV(rv0, 2); A_LOADV(rv1, 3);
  } else if constexpr (DEEP) {
    A_LOADK(rk0, 0); A_LOADV(rv0, 0); A_LOADK(rk1, 1);
    A_WRITEK(rk0, 0); A_WRITEV(rv0, 0); A_WRITEK(rk1, 1);
    A_LOADK(rk0, 2); A_LOADV(rv1, 1); A_LOADK(rk1, 3); A_LOADV(rv0, 2);
  } else {
    A_LOADK(rk0, 0); A_LOADV(rv0, 0); A_LOADK(rk1, 1);
    A_WRITEK(rk0, 0); A_WRITEV(rv0, 0); A_WRITEK(rk1, 1);
    A_LOADK(rk0, 2); A_LOADV(rv0, 1);
  }
  __syncthreads();
  if (PROBE != 1) {
    bf16x8 kf0[2 * NKS]; kload(0, kf0); qk(kf0, sa0, sa1);
    float mx = sa0[0];
#pragma unroll
    for (int i = 1; i < 16; ++i) mx = fmaxf(mx, sa0[i]);
#pragma unroll
    for (int i = 0; i < 16; ++i) mx = fmaxf(mx, sa1[i]);
    mx = fmaxf(mx, __shfl_xor(mx, 32));
    const float m0 = (MODE == 2) ? fmaxf(mx, aw.m_init) : mx;
    if (MODE == 2) l = ((lane < 32) ? 1.0f : 0.0f) * fast_exp2(aw.m_init - m0);
    if constexpr (CSHIFT) {
#pragma unroll
      for (int i = 0; i < 16; ++i) cinit[i] = -m0;
      qk(kf0, sa0, sa1);
    } else { msub = m0; }
  }
  __syncthreads();
  if constexpr (PAIR) {
    for (int j = 0; j < nt; j += 4) {
      A_WRITEK(rk0, 3); A_WRITEK(rk1, 0); A_WRITEV(rv0, 2); A_WRITEV(rv1, 3);
      A_LOADK(rk0, j + 5); A_LOADK(rk1, j + 6); A_LOADV(rv0, j + 4); A_LOADV(rv1, j + 5);
      if (PROBE != 1 && j < my_n) step(1, 0, t0 + j, sa0, sa1, sb0, sb1);
      if (PROBE != 1 && j + 1 < my_n) step(2, 1, t0 + j + 1, sb0, sb1, sa0, sa1);
      __syncthreads();
      if (j + 2 >= nt) break;
      A_WRITEK(rk0, 1); A_WRITEK(rk1, 2); A_WRITEV(rv0, 0); A_WRITEV(rv1, 1);
      A_LOADK(rk0, j + 7); A_LOADK(rk1, j + 8); A_LOADV(rv0, j + 6); A_LOADV(rv1, j + 7);
      if (PROBE != 1 && j + 2 < my_n) step(3, 2, t0 + j + 2, sa0, sa1, sb0, sb1);
      if (PROBE != 1 && j + 3 < my_n) step(0, 3, t0 + j + 3, sb0, sb1, sa0, sa1);
      __syncthreads();
    }
  } else
  for (int j = 0; j < nt; j += 2) {
    if constexpr (DEEP) { A_WRITEK(rk0, 0); A_WRITEV(rv1, 1); A_LOADK(rk0, j + 4); A_LOADV(rv1, j + 3); }
    else { A_WRITEK(rk0, 0); A_WRITEV(rv0, 1); A_LOADK(rk0, j + 3); A_LOADV(rv0, j + 2); }
    if (PROBE != 1 && j < my_n) step(1, 0, t0 + j, sa0, sa1, sb0, sb1);
    __syncthreads();
    if (j + 1 >= nt) break;
    if constexpr (DEEP) { A_WRITEK(rk1, 1); A_WRITEV(rv0, 0); A_LOADK(rk1, j + 5); A_LOADV(rv0, j + 4); }
    else { A_WRITEK(rk0, 1); A_WRITEV(rv0, 0); A_LOADK(rk0, j + 4); A_LOADV(rv0, j + 3); }
    if (PROBE != 1 && j + 1 < my_n) step(0, 1, t0 + j + 1, sb0, sb1, sa0, sa1);
    __syncthreads();
  }
#undef A_LOADK
#undef A_LOADV
#undef A_WRITEK
#undef A_WRITEV
  const float lt = l + __shfl_xor(l, 32);
  const float inv = 1.0f / lt;
  u32x2 gv[2][4];
#pragma unroll
  for (int db = 0; db < 2; ++db)
#pragma unroll
    for (int g = 0; g < 4; ++g) gv[db][g] = *(const u32x2*)(aw.gate + (size_t)r * NP + db * 32 + 8 * g + 4 * h);
#pragma unroll
  for (int db = 0; db < 2; ++db) {
#pragma unroll
    for (int g = 0; g < 4; ++g) {
      const int d0 = db * 32 + 8 * g + 4 * h;
      float v[4];
#pragma unroll
      for (int j = 0; j < 4; ++j) v[j] = (db == 0 ? o0[4 * g + j] : o1[4 * g + j]) * inv;
      v[0] *= silu_f(lo_f(gv[db][g].x)); v[1] *= silu_f(hi_f(gv[db][g].x));
      v[2] *= silu_f(lo_f(gv[db][g].y)); v[3] *= silu_f(hi_f(gv[db][g].y));
      if (PROBE == 0) *(u32x2*)(aw.out + (size_t)r * DM + d0) = mk2(pack2(v[0], v[1]), pack2(v[2], v[3]));
      else if (v[0] == 123.456f) *(u32x2*)(aw.out + (size_t)r * DM + d0) = mk2(pack2(v[0], v[1]), pack2(v[2], v[3]));
    }
  }
}

struct WorkQ { unsigned* ctr; int x; int dx; int per; int* slot; };
DI WorkQ wq_init(const Params& p, int l, int phase, int x, int per, char* smem) {
  WorkQ w; w.ctr = (unsigned*)(p.ws + OFF_WQ) + ((size_t)(l * 4 + phase) * 8) * 16; w.x = x & 0x107; w.dx = 0; w.per = per;
  w.slot = (int*)(smem + SM_ITEM);
  return w;
}
DI int wq_next(WorkQ& w, int& q) {
  for (;;) {
    if (w.dx >= 8) return -1;
    q = (w.x + w.dx) & 7;
    __syncthreads();
    if (threadIdx.x == 0) *w.slot = (int)__hip_atomic_fetch_add(&w.ctr[q * 16], 1u, __ATOMIC_RELAXED, __HIP_MEMORY_SCOPE_AGENT);
    __syncthreads();
    const int t = __builtin_amdgcn_readfirstlane(*w.slot);
    if (t < w.per) return t;
    w.dx += (w.x & 0x100) ? 8 : 1;
  }
}

DI void phase_gemm(const Params& p, int l, int which, int cperm, pg8::PG8_LAS_T lds) {
  char* ws = p.ws;
  pg8::Gemm g; pg8::EpiBf16 E;
  if (which == 0) { g.A = (const u16*)(ws + OFF_XB); g.Bt = (const u16*)(ws + OFF_WIN) + (size_t)l * NP * DM; g.M = T_TOK; g.N = NP; E.O = (u16*)(ws + OFF_PROJ); }
  else if (which == 1) { g.A = (const u16*)(ws + OFF_MEMB); g.Bt = (const u16*)(ws + OFF_WMKV); g.M = 4096; g.N = 2048; E.O = (u16*)(ws + OFF_KVMEM); }
  else { g.A = (const u16*)(ws + OFF_GATED); g.Bt = (const u16*)(ws + OFF_WOUT) + (size_t)l * DM * DM; g.M = T_TOK; g.N = DM; E.O = (u16*)(ws + OFF_PROJ); }
  g.K = DM; E.ldc = g.N; E.nt = (which == 0) ? 1 : 0;
  pg8::StaticOrder S; S.init(g.M, g.N, (int)gridDim.x, cperm);
  pg8::gemm_phase<pg8::EpiBf16, pg8::StaticOrder, false>(lds, g, S, E, nullptr);
}

template <int NHD, class SrcF, class DstF>
DI void vt_strip(SrcF src_of, int src_ld, DstF dst_of, int dst_ld, u16* T, int tid_in) {
  int tid = tid_in; asm volatile("" : "+v"(tid));
  const int rr = tid >> 3, ch = tid & 7;
  u32x4 v[NHD];
#pragma unroll
  for (int hd = 0; hd < NHD; ++hd) v[hd] = __builtin_nontemporal_load((const u32x4*)(src_of(hd) + (size_t)rr * src_ld + ch * 8));
#pragma unroll
  for (int hd = 0; hd < NHD; ++hd) {
    u16* Th = T + hd * (64 * 72);
    const unsigned w[4] = {v[hd].x, v[hd].y, v[hd].z, v[hd].w};
#pragma unroll
    for (int j = 0; j < 4; ++j) {
      Th[(ch * 8 + 2 * j) * 72 + ((rr + 8 * ch) & 63)] = (u16)(w[j] & 0xffffu);
      Th[(ch * 8 + 2 * j + 1) * 72 + ((rr + 8 * ch) & 63)] = (u16)(w[j] >> 16);
    }
  }
  __syncthreads();
#pragma unroll
  for (int hd = 0; hd < NHD; ++hd)
    *(u32x4*)(dst_of(hd) + (size_t)rr * dst_ld + ch * 8) = *(const u32x4*)(T + hd * (64 * 72) + rr * 72 + ((ch + (rr >> 3)) & 7) * 8);
  __syncthreads();
}

DI void phase_b1(const Params& p, int l, int xcd, char* smem) {
  char* ws = p.ws;
  u16* proj = (u16*)(ws + OFF_PROJ);
  const int tid = opaque_tid();
  {
    float* rs = (float*)(smem + SM_RS);
    WorkQ w = wq_init(p, l, 1, xcd, 64, smem);
    for (;;) {
      int q; const int u2 = wq_next(w, q);
      if (u2 < 0) break;
      const int grp = u2 >> 5, mt = 32 * q + (u2 & 31);
      const int m0 = mt * 256;
      Epi e{};
      if (grp == 0) {
        mla_load_a<6>(proj, m0, C_BCQ, smem, tid);
        if (tid < 256) compute_rs<192>(proj, m0, C_BCQ, rs, tid);
        __syncthreads();
        e.out = (u16*)(ws + OFF_QB); e.c32 = (const float*)(ws + OFF_COS32); e.s32 = (const float*)(ws + OFF_SIN32);
        for (int j = 0; j < 3; ++j)
          mla_tile8<M_UQ, 6>((const u16*)(ws + OFF_WUQ) + (size_t)l * 384 * 192, 192, m0, j * 128, e, smem, rs, tid);
      } else {
        mla_load_a<4>(proj, m0, C_BCKV, smem, tid);
        if (tid < 256) compute_rs<128>(proj, m0, C_BCKV, rs, tid);
        __syncthreads();
        const u16* wk = (const u16*)(ws + OFF_WUKV) + (size_t)l * 512 * 128;
        e.out = (u16*)(ws + OFF_KB);
        for (int nt = 0; nt < 2; ++nt)
          mla_tile8<M_UKVK, 4>(wk, 128, m0, nt * 128, e, smem, rs, tid);
        e.vt = (u16*)(ws + OFF_VTB); e.seq = SEQ; e.nseg0 = 256; e.hrows = 256;
        for (int nt = 2; nt < 4; ++nt)
          mla_tile8<M_UKVV, 4>(wk, 128, m0, nt * 128, e, smem, rs, tid);
      }
    }
  }
  __syncthreads();
  {
    u16* T = (u16*)smem;
    for (int tt = blockIdx.x; tt < 1024; tt += gridDim.x) {
      const int b = tt >> 6, s0 = (tt & 63) * 64;
      const u16* srow = proj + (size_t)tt * 64 * NP;
      u16* vta = (u16*)(ws + OFF_VTA) + ((size_t)(b * 4) * 64) * SEQ + s0;
      u16* vtc = (u16*)(ws + OFF_VTC) + ((size_t)(b * 2) * 64) * SEQ + s0;
      vt_strip<6>([&](int hd) { return srow + (hd < 4 ? C_AV + hd * 64 : C_CV + (hd - 4) * 64); }, NP,
                  [&](int hd) { return hd < 4 ? vta + (size_t)hd * 64 * SEQ : vtc + (size_t)(hd - 4) * 64 * SEQ; }, SEQ, T, tid);
    }
    if (l == 0) {
      for (int v = blockIdx.x; v < 256; v += gridDim.x) {
        const int ll = v >> 6, tt = v & 63;
        const int b = tt >> 2, s0 = (tt & 3) * 64;
        const u16* srow = (const u16*)(ws + OFF_KVMEM) + (size_t)tt * 64 * 2048 + ll * 512 + 256;
        u16* vtm = (u16*)(ws + OFF_VTMEM) + ((size_t)ll * 4096 + (size_t)(b * 4) * 64) * 256 + s0;
        vt_strip<4>([&](int hd) { return srow + hd * 64; }, 2048,
                    [&](int hd) { return vtm + (size_t)hd * 64 * 256; }, 256, T, tid);
      }
    }
  }
  const size_t gtid = (size_t)blockIdx.x * NTHR + tid;
  const size_t gn = (size_t)gridDim.x * NTHR;
  const float* c64 = (const float*)(ws + OFF_COS64); const float* s64 = (const float*)(ws + OFF_SIN64);
  const float* c32 = (const float*)(ws + OFF_COS32); const float* s32 = (const float*)(ws + OFF_SIN32);
  for (size_t i = gtid; i < (size_t)T_TOK * 24; i += gn) {
    const int tok = (int)(i / 24), u = (int)(i % 24);
    const int slot = u >> 2, c = u & 3;
    const int col0 = (slot < 4) ? (C_CQ + slot * 64) : (C_CK + (slot - 4) * 64);
    u16* p1 = proj + (size_t)tok * NP + col0 + 8 * c;
    const u32x4 a = *(const u32x4*)p1, b = *(const u32x4*)(p1 + 32);
    const f32x4 ca = *(const f32x4*)(c64 + (size_t)tok * 32 + 8 * c), cb = *(const f32x4*)(c64 + (size_t)tok * 32 + 8 * c + 4);
    const f32x4 sa = *(const f32x4*)(s64 + (size_t)tok * 32 + 8 * c), sb = *(const f32x4*)(s64 + (size_t)tok * 32 + 8 * c + 4);
    const float cs[8] = {ca.x, ca.y, ca.z, ca.w, cb.x, cb.y, cb.z, cb.w};
    const float sn[8] = {sa.x, sa.y, sa.z, sa.w, sb.x, sb.y, sb.z, sb.w};
    const unsigned aw_[4] = {a.x, a.y, a.z, a.w}, bw_[4] = {b.x, b.y, b.z, b.w};
    unsigned o1[4], o2[4];
#pragma unroll
    for (int j = 0; j < 4; ++j) {
      const float x1a = lo_f(aw_[j]), x1b = hi_f(aw_[j]), x2a = lo_f(bw_[j]), x2b = hi_f(bw_[j]);
      o1[j] = pack2(x1a * cs[2 * j] - x2a * sn[2 * j], x1b * cs[2 * j + 1] - x2b * sn[2 * j + 1]);
      o2[j] = pack2(x2a * cs[2 * j] + x1a * sn[2 * j], x2b * cs[2 * j + 1] + x1b * sn[2 * j + 1]);
    }
    *(u32x4*)p1 = mk4(o1[0], o1[1], o1[2], o1[3]);
    *(u32x4*)(p1 + 32) = mk4(o2[0], o2[1], o2[2], o2[3]);
  }
  u16* kB = (u16*)(ws + OFF_KB);
  for (size_t i = gtid; i < (size_t)T_TOK * 2; i += gn) {
    const int tok = (int)(i >> 1), c = (int)(i & 1);
    const u16* p1 = proj + (size_t)tok * NP + C_BKR + 8 * c;
    const u32x4 a = *(const u32x4*)p1, b = *(const u32x4*)(p1 + 16);
    const f32x4 ca = *(const f32x4*)(c32 + (size_t)tok * 16 + 8 * c), cb = *(const f32x4*)(c32 + (size_t)tok * 16 + 8 * c + 4);
    const f32x4 sa = *(const f32x4*)(s32 + (size_t)tok * 16 + 8 * c), sb = *(const f32x4*)(s32 + (size_t)tok * 16 + 8 * c + 4);
    const float cs[8] = {ca.x, ca.y, ca.z, ca.w, cb.x, cb.y, cb.z, cb.w};
    const float sn[8] = {sa.x, sa.y, sa.z, sa.w, sb.x, sb.y, sb.z, sb.w};
    const unsigned aw_[4] = {a.x, a.y, a.z, a.w}, bw_[4] = {b.x, b.y, b.z, b.w};
    unsigned o1[4], o2[4];
#pragma unroll
    for (int j = 0; j < 4; ++j) {
      const float x1a = lo_f(aw_[j]), x1b = hi_f(aw_[j]), x2a = lo_f(bw_[j]), x2b = hi_f(bw_[j]);
      o1[j] = pack2(x1a * cs[2 * j] - x2a * sn[2 * j], x1b * cs[2 * j + 1] - x2b * sn[2 * j + 1]);
      o2[j] = pack2(x2a * cs[2 * j] + x1a * sn[2 * j], x2b * cs[2 * j + 1] + x1b * sn[2 * j + 1]);
    }
#pragma unroll
    for (int hh = 0; hh < 4; ++hh) {
      u16* d = kB + (size_t)tok * 384 + hh * 96 + 64 + 8 * c;
      *(u32x4*)d = mk4(o1[0], o1[1], o1[2], o1[3]);
      *(u32x4*)(d + 16) = mk4(o2[0], o2[1], o2[2], o2[3]);
    }
  }
}

DI void phase_att(const Params& p, int l, int xcd, char* smem) {
  char* ws = p.ws;
  const int tid = opaque_tid();
  const int wave = __builtin_amdgcn_readfirstlane(tid >> 6);
  const u16* proj = (const u16*)(ws + OFF_PROJ);
  u16* gated = (u16*)(ws + OFF_GATED);
  float* biasl = (float*)(smem + SM_BIAS);
  for (int i = tid; i < 4 * 257; i += NTHR) biasl[i] = p.rel_bias[(size_t)l * 4 * 257 + i] * LOG2E;
  __syncthreads();
  WorkQ w = wq_init(p, l, 2, xcd, 512, smem);
  for (;;) {
    int q; const int u = wq_next(w, q);
    if (u < 0) break;
    AttnBlk ab{}; AttnWave aw{};
    aw.m_init = -1e30f; aw.l_init = 0.f;
    if (u < 128) {
      const int i2 = 15 - (u >> 3), pr = 8 * q + (u & 7), b = pr >> 2, hh = pr & 3;
      const int qb = 2 * i2 + (wave >> 2);
      const size_t tok0 = (size_t)b * SEQ + qb * 128 + (wave & 3) * 32;
      ab.k = (const u16*)(ws + OFF_KB) + (size_t)b * SEQ * 384 + hh * 96; ab.k_ld = 384;
      ab.vt = (const u16*)(ws + OFF_VTB) + ((size_t)b * 256 + hh * 64) * SEQ; ab.vt_ld = SEQ;
      ab.kt_begin = 0; ab.kt_end = 4 * i2 + 4; ab.c = 0;
      aw.q = (const u16*)(ws + OFF_QB) + tok0 * 384 + hh * 96; aw.q_ld = 384;
      aw.gate = proj + tok0 * NP + C_BG + hh * 64;
      aw.out = gated + tok0 * DM + 256 + hh * 64;
      aw.hoff = 0; aw.my_kt_end = 2 * qb + 1 + ((wave >> 1) & 1);
      attn_item<96, 1, 0>(ab, aw, smem, tid);
    } else if (u < 256) {
      const int it = u - 128;
      const int c = 63 - (it >> 1), b = 2 * q + (it & 1);
      const int head = wave >> 1;
      const size_t tok0 = (size_t)b * SEQ + c * 64 + (wave & 1) * 32;
      ab.k = proj + (size_t)b * SEQ * NP + C_AK; ab.k_ld = NP;
      ab.vt = (const u16*)(ws + OFF_VTA) + ((size_t)b * 256) * SEQ; ab.vt_ld = SEQ;
      ab.kt_begin = c - 8 < 0 ? 0 : c - 8; ab.kt_end = c + 1; ab.c = c;
      aw.q = proj + tok0 * NP + C_AQ + head * 64; aw.q_ld = NP;
      aw.gate = proj + tok0 * NP + C_AG + head * 64;
      aw.out = gated + tok0 * DM + head * 64;
      aw.hoff = head; aw.my_kt_end = c + 1;
      aw.bias = biasl + head * 257; aw.qi0 = (wave & 1) * 32;
      attn_item<64, 4, 1>(ab, aw, smem, tid);
    } else if (u < 384) {
      const int it = u - 256;
      const int c = it >> 1, b = 2 * q + (it & 1);
      const int head = wave >> 1;
      const size_t tok0 = (size_t)b * SEQ + c * 64 + (wave & 1) * 32;
      ab.k = (const u16*)(ws + OFF_KVMEM) + (size_t)(b * 256) * 2048 + l * 512; ab.k_ld = 2048;
      ab.vt = (const u16*)(ws + OFF_VTMEM) + ((size_t)l * 4096 + b * 256) * 256; ab.vt_ld = 256;
      ab.kt_begin = 0; ab.kt_end = 4; ab.c = 0;
      aw.q = proj + tok0 * NP + C_MQ + head * 64; aw.q_ld = NP;
      aw.gate = proj + tok0 * NP + C_MG + head * 64;
      aw.out = gated + tok0 * DM + 768 + head * 64;
      aw.hoff = head; aw.my_kt_end = 4;
      attn_item<64, 4, 0>(ab, aw, smem, tid);
    } else {
      const int it = u - 384;
      const int c = it >> 1, b = 2 * q + (it & 1);
      const int kvh = wave >> 2, head = 2 * kvh + ((wave >> 1) & 1);
      const size_t tok0 = (size_t)b * SEQ + c * 64 + (wave & 1) * 32;
      ab.k = proj + (size_t)b * SEQ * NP + C_CK; ab.k_ld = NP;
      ab.vt = (const u16*)(ws + OFF_VTC) + ((size_t)b * 128) * SEQ; ab.vt_ld = SEQ;
      ab.kt_begin = c - 2 < 0 ? 0 : c - 2; ab.kt_end = c + 1; ab.c = c;
      aw.q = proj + tok0 * NP + C_CQ + head * 64; aw.q_ld = NP;
      aw.gate = proj + tok0 * NP + C_CG + head * 64;
      aw.out = gated + tok0 * DM + 512 + head * 64;
      aw.hoff = kvh; aw.my_kt_end = c + 1;
      aw.m_init = p.sinks[l * 4 + head] * LOG2E;
      attn_item<64, 2, 2>(ab, aw, smem, tid);
    }
  }
}

DI void phase_ln(const Params& p, int l) {
  char* ws = p.ws;
  u16* xb = (u16*)(ws + OFF_XB);
  const int tid = opaque_tid();
  const int lane = tid & 63;
  const int gw = blockIdx.x * 8 + (tid >> 6), nw = gridDim.x * 8;
  const float* g = p.ln_g + l * DM; const float* bb = p.ln_b + l * DM;
  const float* xin = (l == 0) ? p.x : p.out;
  const u16* yb = (const u16*)(ws + OFF_PROJ);
  const float alpha = 1.681792830507429f;
  f32x4 gv[4], bv[4];
#pragma unroll
  for (int i = 0; i < 4; ++i) { gv[i] = *(const f32x4*)(g + i * 256 + lane * 4); bv[i] = *(const f32x4*)(bb + i * 256 + lane * 4); }
  for (int row0 = gw * 4; row0 < T_TOK; row0 += nw * 4) {
    f32x4 v[4][4]; u32x2 yv[4][4];
#pragma unroll
    for (int rr = 0; rr < 4; ++rr)
#pragma unroll
      for (int i = 0; i < 4; ++i) {
        v[rr][i] = __builtin_nontemporal_load((const f32x4*)(xin + (size_t)(row0 + rr) * DM + i * 256 + lane * 4));
        yv[rr][i] = __builtin_nontemporal_load((const u32x2*)(yb + (size_t)(row0 + rr) * DM + i * 256 + lane * 4));
      }
#pragma unroll
    for (int rr = 0; rr < 4; ++rr)
#pragma unroll
      for (int i = 0; i < 4; ++i) {
        v[rr][i].x = alpha * v[rr][i].x + lo_f(yv[rr][i].x); v[rr][i].y = alpha * v[rr][i].y + hi_f(yv[rr][i].x);
        v[rr][i].z = alpha * v[rr][i].z + lo_f(yv[rr][i].y); v[rr][i].w = alpha * v[rr][i].w + hi_f(yv[rr][i].y);
      }
#pragma unroll
    for (int rr = 0; rr < 4; ++rr) {
      float* rp = p.out + (size_t)(row0 + rr) * DM;
      float s = 0.f;
#pragma unroll
      for (int i = 0; i < 4; ++i) s += v[rr][i].x + v[rr][i].y + v[rr][i].z + v[rr][i].w;
#pragma unroll
      for (int o = 32; o >= 1; o >>= 1) s += __shfl_xor(s, o);
      const float mu = s * (1.0f / 1024.0f);
      float q = 0.f;
#pragma unroll
      for (int i = 0; i < 4; ++i) {
        v[rr][i].x -= mu; v[rr][i].y -= mu; v[rr][i].z -= mu; v[rr][i].w -= mu;
        q += v[rr][i].x * v[rr][i].x + v[rr][i].y * v[rr][i].y + v[rr][i].z * v[rr][i].z + v[rr][i].w * v[rr][i].w;
      }
#pragma unroll
      for (int o = 32; o >= 1; o >>= 1) q += __shfl_xor(q, o);
      const float rstd = rsqrtf(q * (1.0f / 1024.0f) + 1e-5f);
#pragma unroll
      for (int i = 0; i < 4; ++i) {
        f32x4 y;
        y.x = v[rr][i].x * rstd * gv[i].x + bv[i].x;
        y.y = v[rr][i].y * rstd * gv[i].y + bv[i].y;
        y.z = v[rr][i].z * rstd * gv[i].z + bv[i].z;
        y.w = v[rr][i].w * rstd * gv[i].w + bv[i].w;
        __builtin_nontemporal_store(y, (f32x4*)(rp + i * 256 + lane * 4));
        if (l + 1 < DEPTH) *(u32x2*)(xb + (size_t)(row0 + rr) * DM + i * 256 + lane * 4) = mk2(pack2(y.x, y.y), pack2(y.z, y.w));
      }
    }
  }
}

#define XB_TMO      128
#define XB_XCNT(j)  (256  + 64 * (j))
#define XB_XSUB(j)  (1280 + 64 * (j))
#define XB_XGEN(j)  (2304 + 64 * (j))
#define XB_TOP      3328
#define XB_TOPGEN   3392
#define XB_SPIN_CAP (1u << 22)
#define LAS __attribute__((address_space(3)))
DI unsigned xb_ld(unsigned* p) { return __hip_atomic_load(p, __ATOMIC_RELAXED, __HIP_MEMORY_SCOPE_AGENT); }
DI unsigned xb_add(unsigned* p, unsigned v) { return __hip_atomic_fetch_add(p, v, __ATOMIC_RELAXED, __HIP_MEMORY_SCOPE_AGENT); }
DI unsigned xb_xcc_id() { return (unsigned)__builtin_amdgcn_s_getreg((3 << 11) | 20) & 0xFu; }
#define XB_SPIN(cond, bar) do { unsigned _sp = 0; while (cond) { __builtin_amdgcn_s_sleep(1); \
    if ((++_sp & 255u) == 0u) { if (xb_ld(&(bar)[XB_TMO])) break; if (_sp > XB_SPIN_CAP) { atomicAdd(&(bar)[XB_TMO], 1u); break; } } } } while (0)
struct XcdBarrier { unsigned* bar; unsigned x; volatile LAS unsigned* st; unsigned rank; };
DI XcdBarrier xcd_barrier_post(unsigned* bar, volatile LAS unsigned* st) {
  XcdBarrier b; b.bar = bar; b.x = xb_xcc_id(); b.st = st;
  b.rank = 0u;
  if (threadIdx.x == 0) b.rank = xb_add(&bar[XB_XCNT(b.x)], 1u);
  return b;
}
DI void xcd_barrier_complete(unsigned* bar, unsigned x, unsigned& nloc, unsigned& nx) {
  const unsigned G = gridDim.x * gridDim.y * gridDim.z;
  unsigned sum, cnt, mine, sp = 0u;
  for (;;) {
    sum = 0u; cnt = 0u; mine = 0u;
#pragma unroll
    for (unsigned j = 0; j < 16; ++j) { const unsigned c = xb_ld(&bar[XB_XCNT(j)]); sum += c; cnt += (c > 0u) ? 1u : 0u; mine = (j == x) ? c : mine; }
    if (sum == G) break;
    __builtin_amdgcn_s_sleep(1);
    if ((++sp & 255u) == 0u) { if (xb_ld(&bar[XB_TMO])) break; if (sp > XB_SPIN_CAP) { atomicAdd(&bar[XB_TMO], 1u); break; } }
  }
  nloc = mine > 0u ? mine : 1u; nx = cnt > 0u ? cnt : 1u;
}
DI void xcd_barrier(const XcdBarrier& b) {
  asm volatile("s_waitcnt vmcnt(0)" ::: "memory");
  __syncthreads();
  if (threadIdx.x == 0) {
    unsigned* bar = b.bar;
    __builtin_amdgcn_s_waitcnt(0);
    unsigned nloc = b.st[0], nx = b.st[1];
    if (nloc == 0u) { xcd_barrier_complete(bar, b.x, nloc, nx); b.st[0] = nloc; b.st[1] = nx; }
    const unsigned old = xb_add(&bar[XB_XSUB(b.x)], 1u);
    const unsigned gen = old / nloc;
    if (old + 1u == (gen + 1u) * nloc) {
      __builtin_amdgcn_fence(__ATOMIC_RELEASE, "agent");
      asm volatile("s_waitcnt vmcnt(0)" ::: "memory");
      const unsigned og = xb_add(&bar[XB_TOP], 1u);
      const unsigned tg = og / nx;
      if (og + 1u == (tg + 1u) * nx) xb_add(&bar[XB_TOPGEN], 1u);
      else XB_SPIN(xb_ld(&bar[XB_TOPGEN]) == tg, bar);
      __builtin_amdgcn_fence(__ATOMIC_ACQUIRE, "agent");
      xb_add(&bar[XB_XGEN(b.x)], 1u);
      asm volatile("s_waitcnt vmcnt(0)" ::: "memory");
    } else {
      XB_SPIN(xb_ld(&bar[XB_XGEN(b.x)]) == gen, bar);
      __builtin_amdgcn_fence(__ATOMIC_ACQUIRE, "agent");
      asm volatile("s_waitcnt vmcnt(0)" ::: "memory");
    }
  }
  __syncthreads();
}

__global__ void __launch_bounds__(NTHR, 2) fwd_megakernel(Params p) {
  cg::grid_group grid = cg::this_grid();
  extern __shared__ __attribute__((aligned(16))) unsigned char shm[];
  char* smem = (char*)shm;
  pg8::PG8_LAS_T lds = (pg8::PG8_LAS_T)shm;
  if (threadIdx.x < 8) ((unsigned*)(smem + SM_XB))[threadIdx.x] = 0u;
  __syncthreads();
  XcdBarrier xb = xcd_barrier_post((unsigned*)(p.ws + OFF_BAR), (volatile LAS unsigned*)(smem + SM_XB));
  phase0(p, smem);
  if (p.use_cg_sync) grid.sync();
  xcd_barrier(xb);
  int cperm, xcd_arg;
  {
    unsigned* bar = (unsigned*)(p.ws + OFF_BAR);
    if (threadIdx.x == 0) {
      const unsigned G = gridDim.x; bool uni = (G % 8u) == 0u; unsigned sum = 0u;
      for (unsigned j = 0; j < 16; ++j) { const unsigned c = xb_ld(&bar[XB_XCNT(j)]); sum += c; if (j < 8 ? (c != G / 8u) : (c != 0u)) uni = false; }
      if (sum != G) uni = false;
      *(int*)(smem + SM_ITEM) = uni ? (int)(0x10000u | (xb.x + 8u * xb.rank)) : (int)blockIdx.x;
    }
    __syncthreads();
    const int packed = __builtin_amdgcn_readfirstlane(*(int*)(smem + SM_ITEM));
    cperm = packed & 0xffff;
    xcd_arg = (int)xb.x | ((packed >> 16) ? 0x100 : 0);
    __syncthreads();
  }
  for (int ph = 0; ph < DEPTH * 5; ++ph) {
    const int l = ph / 5, k = ph % 5;
    if (k == 0 || k == 3) {
      const int nsub = (k == 0 && l == 0) ? 2 : 1;
      for (int sub = 0; sub < nsub; ++sub) phase_gemm(p, l, (k == 3) ? 2 : sub, cperm, lds);
    } else if (k == 1) phase_b1(p, l, xcd_arg, smem);
    else if (k == 2) phase_att(p, l, xcd_arg, smem);
    else phase_ln(p, l);
    if (ph + 1 < DEPTH * 5) xcd_barrier(xb);
  }
}

extern "C" void kernel_launch(void* const* d_in, const int* in_sizes, int n_in, void* d_out,
                              int out_size, void* d_ws, size_t ws_size, hipStream_t stream) {
  static int grid_blocks = 0;
  if (!grid_blocks) {
    int dev = 0, cus = 0, per_cu = 0;
    (void)hipGetDevice(&dev);
    (void)hipDeviceGetAttribute(&cus, hipDeviceAttributeMultiprocessorCount, dev);
    if (hipFuncSetAttribute((const void*)fwd_megakernel, hipFuncAttributeMaxDynamicSharedMemorySize, SM_TOTAL) != hipSuccess) {
      fprintf(stderr, "kernel_launch: hipFuncSetAttribute failed (%d bytes of dynamic LDS)\n", SM_TOTAL); return; }
    if (hipOccupancyMaxActiveBlocksPerMultiprocessor(&per_cu, (const void*)fwd_megakernel, NTHR, SM_TOTAL) != hipSuccess || per_cu < 1) {
      fprintf(stderr, "kernel_launch: occupancy query failed\n"); return; }
    grid_blocks = cus;
  }
  if (ws_size < WS_NEEDED) { fprintf(stderr, "workspace too small: %zu < %zu\n", ws_size, (size_t)WS_NEEDED); return; }
  Params p{};
  p.x = (const float*)d_in[0]; p.mem = (const float*)d_in[1]; p.pos = (const int*)d_in[2];
  p.w_in = (const float*)d_in[3]; p.rel_bias = (const float*)d_in[4]; p.q_norm = (const float*)d_in[5];
  p.w_uq = (const float*)d_in[6]; p.kv_norm = (const float*)d_in[7]; p.w_ukv = (const float*)d_in[8];
  p.sinks = (const float*)d_in[9]; p.w_mem_kv = (const float*)d_in[10]; p.w_out = (const float*)d_in[11];
  p.ln_g = (const float*)d_in[12]; p.ln_b = (const float*)d_in[13];
  p.out = (float*)d_out; p.ws = (char*)d_ws; p.use_cg_sync = 0; p.pad_ = 0;
  (void)hipMemsetAsync((char*)d_ws + OFF_BAR, 0, ZERO_BYTES, stream);
  void* args[] = {&p};
  hipError_t e = hipLaunchCooperativeKernel((void*)fwd_megakernel, dim3(grid_blocks), dim3(NTHR), args, SM_TOTAL, stream);
  if (e != hipSuccess) fprintf(stderr, "cooperative launch failed: %s (grid %d)\n", hipGetErrorString(e), grid_blocks);
}
```
